# Optimizing an MI355X kernel written in HIP

```python
import jax
import jax.numpy as jnp
from jax import lax
import numpy as np

D_MODEL = 1024
BATCH = 8
SEQ = 8192
DEPTH = 2

CTX_LEN = 256
GRID_W = 64
HEAD_DIM = 64
GLA_HEADS = 4
GLA_DK = 32
GLA_DV = 64
GLA_GATE_RANK = 16
GLA_GATE_TAU = 16.0
GLA_CHUNK = 64
GLB_HEADS = 8
GLB_KV_HEADS = 2
WIN_HEADS = 4
WIN_KV_HEADS = 2
WINDOW = 128
Q_BLOCK = 128
FFN_HIDDEN = 2816
ROPE_BASE = 10000.0
N_MOD = 9
EPS = 1e-6
MIX_WIDTH = GLA_HEADS * GLA_DV + GLB_HEADS * HEAD_DIM + WIN_HEADS * HEAD_DIM
IN_SPLITS = (GLA_HEADS * GLA_DK, GLA_HEADS * GLA_DK, GLA_HEADS * GLA_DV, GLA_HEADS * GLA_DV, 2 * GLA_GATE_RANK,
             GLB_HEADS * HEAD_DIM, GLB_KV_HEADS * HEAD_DIM, GLB_KV_HEADS * HEAD_DIM,
             WIN_HEADS * HEAD_DIM, WIN_KV_HEADS * HEAD_DIM, WIN_KV_HEADS * HEAD_DIM)
IN_WIDTH = sum(IN_SPLITS)

kernel_name = 'hymba_style_hybrid_dit_block'


def rms_norm(x, g):
    xf = x.astype(jnp.float32)
    y = xf * lax.rsqrt(jnp.mean(xf * xf, axis=-1, keepdims=True) + EPS)
    return (y * g.astype(jnp.float32)).astype(x.dtype)


def modulate(h, shift, scale):
    return h * (1 + scale) + shift


def swiglu(h, w_in, w_out):
    a, b = jnp.split(h @ w_in, 2, axis=-1)
    return (jax.nn.silu(a) * b) @ w_out


def rope_tables(n_tokens, dtype):
    rows = n_tokens // GRID_W
    row = jnp.repeat(jnp.arange(rows, dtype=jnp.float32), GRID_W)
    col = (jnp.arange(rows * GRID_W) % GRID_W).astype(jnp.float32)
    n_freq = HEAD_DIM // 4
    inv = jnp.power(ROPE_BASE, -jnp.arange(n_freq, dtype=jnp.float32) / n_freq)
    ang = jnp.concatenate([row[:, None] * inv, col[:, None] * inv], axis=-1)
    return jnp.cos(ang)[:, None, :].astype(dtype), jnp.sin(ang)[:, None, :].astype(dtype)


def apply_rope(x, cos, sin):
    x1, x2 = jnp.split(x, 2, axis=-1)
    return jnp.concatenate([x1 * cos - x2 * sin, x1 * sin + x2 * cos], axis=-1)


def gla_scan(q, k, v, g, s0):
    bsz, nh, length, dk = q.shape
    dv = v.shape[-1]
    n = length // GLA_CHUNK
    q = q.reshape(bsz, nh, n, GLA_CHUNK, dk)
    k = k.reshape(bsz, nh, n, GLA_CHUNK, dk)
    v = v.reshape(bsz, nh, n, GLA_CHUNK, dv)
    b = jnp.cumsum(g.reshape(bsz, nh, n, GLA_CHUNK, dk), axis=3)
    gam = b[:, :, :, -1:, :]
    q_in = q * jnp.exp(b)
    a = jnp.einsum('bhncd,bhnsd->bhncs', q_in, k * jnp.exp(-b))
    a = jnp.where(jnp.tril(jnp.ones((GLA_CHUNK, GLA_CHUNK), dtype=bool)), a, 0.0)
    o = jnp.einsum('bhncs,bhnsv->bhncv', a, v)
    ds = jnp.einsum('bhncd,bhncv->bhndv', k * jnp.exp(gam - b), v)
    decay = jnp.exp(gam[:, :, :, 0, :])

    def step(s, inp):
        dec, d = inp
        return dec[..., None] * s + d, s

    s_fin, s_prev = lax.scan(step, s0, (jnp.moveaxis(decay, 2, 0), jnp.moveaxis(ds, 2, 0)))
    o = o + jnp.einsum('bhncd,nbhdv->bhncv', q_in, s_prev)
    return o.reshape(bsz, nh, length, dv), s_fin


def gla_bidir(q, k, v, gf, gb, sf0, sb0):
    of, sf = gla_scan(q, k, v, gf, sf0)
    fl = lambda t: jnp.flip(t, axis=2)
    ob, sb = gla_scan(fl(q), fl(k), fl(v), fl(gb), sb0)
    return of + fl(ob), sf, sb


def gla_prepare(q, k, v, gd, wg_f, bg_f, wg_b, bg_b):
    bsz, length, _ = q.shape

    def heads(t, d):
        return t.astype(jnp.float32).reshape(bsz, length, GLA_HEADS, d).transpose(0, 2, 1, 3)

    gdf, gdb = jnp.split(gd.astype(jnp.float32), 2, axis=-1)
    gf = jax.nn.log_sigmoid(gdf @ wg_f.astype(jnp.float32) + bg_f.astype(jnp.float32)) / GLA_GATE_TAU
    gb = jax.nn.log_sigmoid(gdb @ wg_b.astype(jnp.float32) + bg_b.astype(jnp.float32)) / GLA_GATE_TAU
    return (heads(q, GLA_DK) * GLA_DK ** -0.5, heads(k, GLA_DK), heads(v, GLA_DV),
            heads(gf, GLA_DK), heads(gb, GLA_DK))


def gla_output(o, r, gain):
    bsz, nh, length, dv = o.shape
    o = rms_norm(o.transpose(0, 2, 1, 3), gain)
    gate = jax.nn.silu(r.astype(jnp.float32)).reshape(bsz, length, nh, dv)
    return (o * gate).reshape(bsz, length, nh * dv).astype(r.dtype)


def qk_prep(q, k, q_gain, k_gain, n_q, n_kv, rope):
    bsz, length, _ = q.shape
    q = rms_norm(q.reshape(bsz, length, n_q, HEAD_DIM), q_gain)
    k = rms_norm(k.reshape(bsz, length, n_kv, HEAD_DIM), k_gain)
    if rope is not None:
        cos, sin = rope
        q = apply_rope(q, cos, sin)
        k = apply_rope(k, cos, sin)
    q = q * HEAD_DIM ** -0.5
    return q.reshape(bsz, length, n_kv, n_q // n_kv, HEAD_DIM), k


def dense_attn(q, k, v, sink):
    bsz, nq, n_kv, grp, _ = q.shape
    s = jnp.einsum('bqhgd,bkhd->bhgqk', q, k).astype(jnp.float32)
    if sink is not None:
        snk = jnp.broadcast_to(sink.astype(jnp.float32).reshape(1, n_kv, grp, 1, 1), s.shape[:-1] + (1,))
        s = jnp.concatenate([s, snk], axis=-1)
    p = jax.nn.softmax(s, axis=-1)
    if sink is not None:
        p = p[..., :-1]
    o = jnp.einsum('bhgqk,bkhd->bqhgd', p.astype(v.dtype), v)
    return o.reshape(bsz, nq, -1)


def global_attn_latent(q, k, v):
    bsz, length = q.shape[:2]
    nb = length // Q_BLOCK
    qb = q.reshape((bsz, nb, Q_BLOCK) + q.shape[2:]).swapaxes(0, 1)
    o = lax.map(lambda qi: dense_attn(qi, k, v, None), qb)
    return o.swapaxes(0, 1).reshape(bsz, length, -1)


def window_attn_latent(q, k, v, kc, vc, sink):
    bsz, length, n_kv, grp, hd = q.shape
    nb = length // Q_BLOCK
    qb = q.reshape(bsz, nb, Q_BLOCK, n_kv, grp, hd).swapaxes(0, 1)

    def band(t):
        tp = jnp.pad(t, ((0, 0), (Q_BLOCK, Q_BLOCK), (0, 0), (0, 0))).reshape(bsz, nb + 2, Q_BLOCK, n_kv, hd)
        return jnp.concatenate([tp[:, :-2], tp[:, 1:-1], tp[:, 2:]], axis=2).swapaxes(0, 1)

    rel = jnp.arange(3 * Q_BLOCK)[None, :] - jnp.arange(Q_BLOCK)[:, None]
    in_win = (rel >= Q_BLOCK - WINDOW) & (rel <= Q_BLOCK + WINDOW)
    kpos = (jnp.arange(nb)[:, None] - 1) * Q_BLOCK + jnp.arange(3 * Q_BLOCK)[None, :]
    mask = in_win[None] & ((kpos >= 0) & (kpos < length))[:, None, :]
    snk = jnp.broadcast_to(sink.astype(jnp.float32).reshape(1, n_kv, grp, 1, 1), (bsz, n_kv, grp, Q_BLOCK, 1))
    n_loc = 3 * Q_BLOCK
    n_ctx = kc.shape[1]

    def blk(args):
        qi, ki, vi, mi = args
        s_loc = jnp.einsum('bqhgd,bkhd->bhgqk', qi, ki).astype(jnp.float32)
        s_loc = jnp.where(mi, s_loc, -jnp.inf)
        s_ctx = jnp.einsum('bqhgd,bkhd->bhgqk', qi, kc).astype(jnp.float32)
        p = jax.nn.softmax(jnp.concatenate([s_loc, s_ctx, snk], axis=-1), axis=-1).astype(vi.dtype)
        o = (jnp.einsum('bhgqk,bkhd->bqhgd', p[..., :n_loc], vi)
             + jnp.einsum('bhgqk,bkhd->bqhgd', p[..., n_loc:n_loc + n_ctx], vc))
        return o.reshape(bsz, Q_BLOCK, -1)

    o = lax.map(blk, (qb, band(k), band(v), mask))
    return o.swapaxes(0, 1).reshape(bsz, length, -1)


def mixer(h, hc, rope, w_in, w_out, wg_f, bg_f, wg_b, bg_b, gla_gain,
          glb_qg, glb_kg, win_qg, win_kg, sink, need_ctx):
    bsz, length, _ = h.shape
    n_ctx = hc.shape[1]
    idx = np.cumsum(IN_SPLITS)[:-1]
    aq, ak, av, ar, ad, gq, gk, gv, wq, wk, wv = jnp.split(h @ w_in, idx, axis=-1)
    aqc, akc, avc, arc, adc, gqc, gkc, gvc, wqc, wkc, wvc = jnp.split(hc @ w_in, idx, axis=-1)

    s_zero = jnp.zeros((bsz, GLA_HEADS, GLA_DK, GLA_DV), jnp.float32)
    oc_a, s_f, s_b = gla_bidir(*gla_prepare(aqc, akc, avc, adc, wg_f, bg_f, wg_b, bg_b), s_zero, s_zero)
    o_a, _, _ = gla_bidir(*gla_prepare(aq, ak, av, ad, wg_f, bg_f, wg_b, bg_b), s_f, s_b)

    q_g, k_g = qk_prep(gq, gk, glb_qg, glb_kg, GLB_HEADS, GLB_KV_HEADS, rope)
    qc_g, kc_g = qk_prep(gqc, gkc, glb_qg, glb_kg, GLB_HEADS, GLB_KV_HEADS, None)
    v_g = gv.reshape(bsz, length, GLB_KV_HEADS, HEAD_DIM)
    vc_g = gvc.reshape(bsz, n_ctx, GLB_KV_HEADS, HEAD_DIM)
    o_b = global_attn_latent(q_g, jnp.concatenate([k_g, kc_g], axis=1), jnp.concatenate([v_g, vc_g], axis=1))

    q_w, k_w = qk_prep(wq, wk, win_qg, win_kg, WIN_HEADS, WIN_KV_HEADS, rope)
    qc_w, kc_w = qk_prep(wqc, wkc, win_qg, win_kg, WIN_HEADS, WIN_KV_HEADS, None)
    v_w = wv.reshape(bsz, length, WIN_KV_HEADS, HEAD_DIM)
    vc_w = wvc.reshape(bsz, n_ctx, WIN_KV_HEADS, HEAD_DIM)
    o_c = window_attn_latent(q_w, k_w, v_w, kc_w, vc_w, sink)

    out = jnp.concatenate([gla_output(o_a, ar, gla_gain), o_b, o_c], axis=-1) @ w_out
    if not need_ctx:
        return out, None
    oc = jnp.concatenate([gla_output(oc_a, arc, gla_gain),
                          dense_attn(qc_g, kc_g, vc_g, None),
                          dense_attn(qc_w, kc_w, vc_w, sink)], axis=-1) @ w_out
    return out, oc


def setup_inputs(seed: int = 0) -> dict:
    key = jax.random.key(seed)
    ks = jax.random.split(key, 26)
    f32 = jnp.float32

    def nrm(k, shape, scale):
        return jax.random.normal(k, shape, f32) * scale

    def gain(k, shape):
        return 1.0 + 0.02 * jax.random.normal(k, shape, f32)

    return {
        'x': nrm(ks[0], (BATCH, SEQ, D_MODEL), 1.0),
        'c': nrm(ks[1], (BATCH, D_MODEL), 1.0),
        'ctx': nrm(ks[2], (BATCH, CTX_LEN, D_MODEL), 1.0),
        'c_ctx': nrm(ks[3], (D_MODEL,), 1.0),
        'mod_w': nrm(ks[4], (DEPTH, D_MODEL, N_MOD * D_MODEL), D_MODEL ** -0.5),
        'mod_b': nrm(ks[5], (DEPTH, N_MOD * D_MODEL), 0.02),
        'norm_ffn1': gain(ks[6], (DEPTH, D_MODEL)),
        'ffn1_w_in': nrm(ks[7], (DEPTH, D_MODEL, 2 * FFN_HIDDEN), D_MODEL ** -0.5),
        'ffn1_w_out': nrm(ks[8], (DEPTH, FFN_HIDDEN, D_MODEL), FFN_HIDDEN ** -0.5),
        'norm_mix': gain(ks[9], (DEPTH, D_MODEL)),
        'mix_w_in': nrm(ks[10], (DEPTH, D_MODEL, IN_WIDTH), D_MODEL ** -0.5),
        'mix_w_out': nrm(ks[11], (DEPTH, MIX_WIDTH, D_MODEL), MIX_WIDTH ** -0.5),
        'gla_wg_f': nrm(ks[12], (DEPTH, GLA_GATE_RANK, GLA_HEADS * GLA_DK), GLA_GATE_RANK ** -0.5),
        'gla_bg_f': nrm(ks[13], (DEPTH, GLA_HEADS * GLA_DK), 0.02),
        'gla_wg_b': nrm(ks[14], (DEPTH, GLA_GATE_RANK, GLA_HEADS * GLA_DK), GLA_GATE_RANK ** -0.5),
        'gla_bg_b': nrm(ks[15], (DEPTH, GLA_HEADS * GLA_DK), 0.02),
        'gla_out_norm': gain(ks[16], (DEPTH, GLA_DV)),
        'glb_q_norm': gain(ks[17], (DEPTH, HEAD_DIM)),
        'glb_k_norm': gain(ks[18], (DEPTH, HEAD_DIM)),
        'win_q_norm': gain(ks[19], (DEPTH, HEAD_DIM)),
        'win_k_norm': gain(ks[20], (DEPTH, HEAD_DIM)),
        'win_sink': nrm(ks[21], (DEPTH, WIN_HEADS), 0.5),
        'norm_ffn2': gain(ks[22], (DEPTH, D_MODEL)),
        'ffn2_w_in': nrm(ks[23], (DEPTH, D_MODEL, 2 * FFN_HIDDEN), D_MODEL ** -0.5),
        'ffn2_w_out': nrm(ks[24], (DEPTH, FFN_HIDDEN, D_MODEL), FFN_HIDDEN ** -0.5),
    }


def reference(x, c, ctx, c_ctx, mod_w, mod_b, norm_ffn1, ffn1_w_in, ffn1_w_out, norm_mix, mix_w_in, mix_w_out,
              gla_wg_f, gla_bg_f, gla_wg_b, gla_bg_b, gla_out_norm, glb_q_norm, glb_k_norm,
              win_q_norm, win_k_norm, win_sink, norm_ffn2, ffn2_w_in, ffn2_w_out):
    length = x.shape[1]
    rope = rope_tables(length, x.dtype)
    xc = ctx
    sc = jax.nn.silu(c)
    scc = jax.nn.silu(c_ctx)
    for l in range(DEPTH):
        need_ctx = l < DEPTH - 1
        ml = jnp.split((sc @ mod_w[l] + mod_b[l])[:, None, :], N_MOD, axis=-1)
        mc = jnp.split((scc @ mod_w[l] + mod_b[l])[None, None, :], N_MOD, axis=-1)
        x = x + 0.5 * ml[2] * swiglu(modulate(rms_norm(x, norm_ffn1[l]), ml[0], ml[1]), ffn1_w_in[l], ffn1_w_out[l])
        xc = xc + 0.5 * mc[2] * swiglu(modulate(rms_norm(xc, norm_ffn1[l]), mc[0], mc[1]), ffn1_w_in[l], ffn1_w_out[l])
        h = modulate(rms_norm(x, norm_mix[l]), ml[3], ml[4])
        hc = modulate(rms_norm(xc, norm_mix[l]), mc[3], mc[4])
        o, oc = mixer(h, hc, rope, mix_w_in[l], mix_w_out[l], gla_wg_f[l], gla_bg_f[l], gla_wg_b[l], gla_bg_b[l],
                      gla_out_norm[l], glb_q_norm[l], glb_k_norm[l], win_q_norm[l], win_k_norm[l], win_sink[l],
                      need_ctx)
        x = x + ml[5] * o
        x = x + 0.5 * ml[8] * swiglu(modulate(rms_norm(x, norm_ffn2[l]), ml[6], ml[7]), ffn2_w_in[l], ffn2_w_out[l])
        if need_ctx:
            xc = xc + mc[5] * oc
            xc = xc + 0.5 * mc[8] * swiglu(modulate(rms_norm(xc, norm_ffn2[l]), mc[6], mc[7]),
                                           ffn2_w_in[l], ffn2_w_out[l])
    return x
```

```cpp
#include <hip/hip_runtime.h>
#include <hip/hip_cooperative_groups.h>
#include <cstdio>
#include <cstdint>
namespace cg = cooperative_groups;
__device__ __forceinline__ int opaque_tid() { int t = threadIdx.x; asm volatile("" : "+v"(t)); return t; }
__device__ __forceinline__ int opaque_bid() { int b = blockIdx.x; asm volatile("" : "+s"(b)); return b; }
namespace pg8 {
#define PG8_LAS __attribute__((address_space(3)))
typedef unsigned short bf16_t;
typedef short bf16x8 __attribute__((ext_vector_type(8)));
typedef float f32x4 __attribute__((ext_vector_type(4)));
typedef unsigned u32x4 __attribute__((ext_vector_type(4)));
constexpr int BM = 256, BK = 64, HALF = 128, HTB = HALF * BK * 2  , STAGE_BYTES = 8 * HTB, NXCD = 8, WGM = 8;

__host__ __device__ __forceinline__ int lds_byte(int r, int c) { const int st = (r >> 4) * 2 + (c >> 5), rr = r & 15, cc = c & 31, ob = rr * 64 + cc * 2; return st * 1024 + (ob ^ (((ob >> 9) & 1) << 5)); }
__host__ __device__ __forceinline__ void stage_rc(int b, int& R, int& C) { const int st = b / 1024, sb = b % 1024, swz = sb ^ (((sb >> 9) & 1) << 5); R = (st >> 1) * 16 + swz / 64; C = (st & 1) * 32 + (swz % 64) / 2; }
__host__ __device__ __forceinline__ int perm32(int rho) { const int n = rho >> 4, i = rho & 15; return 8 * (i >> 2) + 4 * n + (i & 3); }

struct Unit { int pm, pn; };
struct Gemm { const bf16_t* A; const bf16_t* Bt; int M, N, K; };

struct StaticOrder {
    int nM, nN, nwg, G, c;
    __host__ __device__ void init(int M, int N, int G_, int c_) { nM = M / BM; nN = N / BM; nwg = nM * nN; G = G_; c = c_; }
    __host__ __device__ bool next(int i, Unit& u) const {
        const long L = (long)i * G + c; if (L >= nwg) return false;
        int wgid = (int)L; { const int q = nwg / NXCD, r = nwg % NXCD, xcd = wgid % NXCD, off = wgid / NXCD; wgid = (xcd < r ? xcd * (q + 1) : r * (q + 1) + (xcd - r) * q) + off; }
        const int nig = WGM * nN, gid = wgid / nig, fm = gid * WGM, gsz = (nM - fm) < WGM ? (nM - fm) : WGM;
        u.pm = fm + ((wgid % nig) % gsz); u.pn = (wgid % nig) / gsz; return true;
    }
    __device__ __forceinline__ void a_ready(const Unit&) const {}
    __device__ __forceinline__ void done(const Unit&) const {}
};

__device__ __forceinline__ unsigned cvt_pk_bf16(float lo, float hi) { unsigned r; asm volatile("v_cvt_pk_bf16_f32 %0, %1, %2" : "=v"(r) : "v"(lo), "v"(hi)); return r; }
typedef float f32x2 __attribute__((ext_vector_type(2)));
template <class Epi, class Sched, bool ALIGN_EPI = false, bool SP2 = false>
__device__ __forceinline__ void gemm_phase(PG8_LAS unsigned char* lds, const Gemm g, const Sched& S, const Epi& E) {
    const int tid = opaque_tid(), wid = __builtin_amdgcn_readfirstlane(tid >> 6), lane = tid & 63, wr = wid >> 2, wc = wid & 3, fr = lane & 15, fq = lane >> 4;
    const int K = g.K, nt = K / BK;
    unsigned voffA[2], voffB[2];
#pragma unroll
    for (int i = 0; i < 2; ++i) { int R, C; stage_rc(tid * 16 + i * 8192, R, C); const int Rb = Epi::PERM ? ((R & ~31) + perm32(R & 31)) : R;
        voffA[i] = (unsigned)(R * K + C) * 2u; voffB[i] = (unsigned)(Rb * K + C) * 2u; }
    const size_t kstep = (size_t)(BK * 2);
    const size_t hstep = (size_t)HALF * K * 2;
    const size_t tstep = 2 * hstep;
    const unsigned ldsw = (unsigned)wid * 1024u;
    const int aoff = lds_byte(wr * 64 + fr, fq * 8), boff = lds_byte(wc * 32 + fr, fq * 8);
#define PG8_SA(b, h) (((b) * 2 + (h)) * HTB)
#define PG8_SB(b, h) ((4 + (b) * 2 + (h)) * HTB)
#define PG8_STAGE(bufoff, gbase, voff) do { _Pragma("unroll") for (int _i = 0; _i < 2; ++_i) \
        __builtin_amdgcn_global_load_lds((const unsigned*)((const char*)(gbase) + (voff)[_i]), (PG8_LAS unsigned*)(lds + (bufoff) + ldsw + _i * 8192), 16, 0, 0); } while (0)
#define PG8_LDA(dst, b, h) do { _Pragma("unroll") for (int m = 0; m < 4; ++m) _Pragma("unroll") for (int k = 0; k < 2; ++k) dst[m][k] = *(const PG8_LAS bf16x8*)(lds + PG8_SA(b, h) + aoff + m * 2048 + k * 1024); } while (0)
#define PG8_LDB(dst, b, h) do { _Pragma("unroll") for (int n = 0; n < 2; ++n) _Pragma("unroll") for (int k = 0; k < 2; ++k) dst[n][k] = *(const PG8_LAS bf16x8*)(lds + PG8_SB(b, h) + boff + n * 2048 + k * 1024); } while (0)
#define PG8_MMA(ai, bj, At, Bt) do { __builtin_amdgcn_s_setprio(1); _Pragma("unroll") for (int m = 0; m < 4; ++m) _Pragma("unroll") for (int n = 0; n < 2; ++n) _Pragma("unroll") for (int k = 0; k < 2; ++k) \
        acc[ai][bj][m][n] = __builtin_amdgcn_mfma_f32_16x16x32_bf16(Bt[n][k], At[m][k], acc[ai][bj][m][n], 0, 0, 0); __builtin_amdgcn_s_setprio(0); } while (0)
#define PG8_WAIT_V(n) asm volatile("s_waitcnt vmcnt(" #n ")" ::: "memory")
#define PG8_WAIT_L(n) asm volatile("s_waitcnt lgkmcnt(" #n ")" ::: "memory")
#define PG8_BAR __builtin_amdgcn_s_barrier()
#define PG8_SCHED __builtin_amdgcn_sched_barrier(0)
    Unit cur, nxt; int ui = 0; typename Epi::Pre pre;
    if (!S.next(0, cur)) return;
    f32x4 acc[2][2][4][2];
#pragma unroll
    for (int a = 0; a < 2; ++a)
#pragma unroll
        for (int b = 0; b < 2; ++b)
#pragma unroll
            for (int m = 0; m < 4; ++m)
#pragma unroll
                for (int n = 0; n < 2; ++n) acc[a][b][m][n] = (f32x4){0.f, 0.f, 0.f, 0.f};
    bf16x8 At[4][2], B0[2][2], B1[2][2];
    const char* cA = (const char*)g.A + (size_t)cur.pm * tstep; const char* cB = (const char*)g.Bt + (size_t)cur.pn * tstep;
    S.a_ready(cur);
    if constexpr (SP2) {
        PG8_STAGE(PG8_SB(0, 0), cB, voffB); PG8_STAGE(PG8_SB(0, 1), cB + hstep, voffB); PG8_STAGE(PG8_SA(0, 0), cA, voffA); PG8_STAGE(PG8_SA(0, 1), cA + hstep, voffA);
        if (wr == 1) PG8_BAR;
        PG8_WAIT_V(2); PG8_BAR;
        PG8_STAGE(PG8_SB(1, 0), cB + kstep, voffB); PG8_STAGE(PG8_SA(1, 0), cA + kstep, voffA); PG8_STAGE(PG8_SB(1, 1), cB + hstep + kstep, voffB);
        PG8_WAIT_V(6); PG8_BAR;
    } else {
        PG8_STAGE(PG8_SB(0, 0), cB, voffB); PG8_STAGE(PG8_SA(0, 0), cA, voffA); PG8_STAGE(PG8_SB(0, 1), cB + hstep, voffB); PG8_STAGE(PG8_SA(0, 1), cA + hstep, voffA);
        if (wr == 1) PG8_BAR;
        PG8_WAIT_V(4); PG8_BAR;
        PG8_STAGE(PG8_SB(1, 0), cB + kstep, voffB); PG8_STAGE(PG8_SA(1, 0), cA + kstep, voffA); PG8_STAGE(PG8_SB(1, 1), cB + hstep + kstep, voffB);
        PG8_WAIT_V(6); PG8_BAR;
    }
    for (;;) {
        const bool has_next = S.next(ui + 1, nxt);
        const char* nA = has_next ? (const char*)g.A + (size_t)nxt.pm * tstep : cA; const char* nB = has_next ? (const char*)g.Bt + (size_t)nxt.pn * tstep : cB;
        for (int t = 0; t < nt; t += 2) {
            const bool last = (t == nt - 2);
            const char* a1 = cA + (size_t)(t + 1) * kstep;
            const char* a2 = last ? nA : cA + (size_t)(t + 2) * kstep; const char* b2 = last ? nB : cB + (size_t)(t + 2) * kstep;
            const char* a3 = a2 + kstep; const char* b3 = b2 + kstep;
            if (last && has_next) S.a_ready(nxt);
            if (last) E.prefetch(cur, wr, fr, pre);
            if constexpr (SP2) {
            PG8_LDB(B0, 0, 0); PG8_LDB(B1, 0, 1); PG8_SCHED; PG8_LDA(At, 0, 0); PG8_STAGE(PG8_SA(1, 1), a1 + hstep, voffA);
            PG8_WAIT_V(8); PG8_WAIT_L(0); PG8_BAR; PG8_MMA(0, 0, At, B0); PG8_MMA(0, 1, At, B1); PG8_BAR; PG8_SCHED;
            PG8_LDA(At, 0, 1); PG8_STAGE(PG8_SB(0, 0), b2, voffB); PG8_STAGE(PG8_SB(0, 1), b2 + hstep, voffB); PG8_STAGE(PG8_SA(0, 0), a2, voffA);
            PG8_WAIT_V(8); PG8_WAIT_L(0); PG8_BAR; PG8_MMA(1, 0, At, B0); PG8_MMA(1, 1, At, B1); PG8_BAR; PG8_SCHED;
            PG8_LDB(B0, 1, 0); PG8_LDB(B1, 1, 1); PG8_SCHED; PG8_LDA(At, 1, 0); PG8_STAGE(PG8_SA(0, 1), a2 + hstep, voffA);
            PG8_WAIT_V(8); PG8_WAIT_L(0); PG8_BAR; PG8_MMA(0, 0, At, B0); PG8_MMA(0, 1, At, B1); PG8_BAR; PG8_SCHED;
            PG8_LDA(At, 1, 1); PG8_STAGE(PG8_SB(1, 0), b3, voffB); PG8_STAGE(PG8_SB(1, 1), b3 + hstep, voffB); PG8_STAGE(PG8_SA(1, 0), a3, voffA);
            PG8_WAIT_V(8); PG8_WAIT_L(0); PG8_BAR; PG8_MMA(1, 0, At, B0); PG8_MMA(1, 1, At, B1); PG8_BAR; PG8_SCHED;
            } else {
            PG8_LDB(B0, 0, 0); PG8_SCHED; PG8_LDA(At, 0, 0); PG8_STAGE(PG8_SA(1, 1), a1 + hstep, voffA);
            PG8_WAIT_L(8); PG8_BAR; PG8_WAIT_L(0); PG8_MMA(0, 0, At, B0); PG8_BAR; PG8_SCHED;
            PG8_LDB(B1, 0, 1); PG8_STAGE(PG8_SB(0, 0), b2, voffB);
            PG8_BAR; PG8_WAIT_L(0); PG8_MMA(0, 1, At, B1); PG8_BAR;
            PG8_LDA(At, 0, 1); PG8_STAGE(PG8_SA(0, 0), a2, voffA);
            PG8_BAR; PG8_WAIT_L(0); PG8_MMA(1, 0, At, B0); PG8_BAR; PG8_SCHED;
            PG8_STAGE(PG8_SB(0, 1), b2 + hstep, voffB);
            PG8_WAIT_V(6); PG8_BAR; PG8_MMA(1, 1, At, B1); PG8_BAR;
            PG8_LDB(B0, 1, 0); PG8_SCHED; PG8_LDA(At, 1, 0); PG8_STAGE(PG8_SA(0, 1), a2 + hstep, voffA);
            PG8_WAIT_L(8); PG8_BAR; PG8_WAIT_L(0); PG8_MMA(0, 0, At, B0); PG8_BAR; PG8_SCHED;
            PG8_LDB(B1, 1, 1); PG8_STAGE(PG8_SB(1, 0), b3, voffB);
            PG8_BAR; PG8_WAIT_L(0); PG8_MMA(0, 1, At, B1); PG8_BAR;
            PG8_LDA(At, 1, 1); PG8_STAGE(PG8_SA(1, 0), a3, voffA);
            PG8_BAR; PG8_WAIT_L(0); PG8_MMA(1, 0, At, B0); PG8_BAR; PG8_SCHED;
            PG8_STAGE(PG8_SB(1, 1), b3 + hstep, voffB);
            PG8_WAIT_V(6); PG8_BAR; PG8_MMA(1, 1, At, B1); PG8_BAR;
            }
        }
        if constexpr (ALIGN_EPI) { if (wr == 0) PG8_BAR; }
        if constexpr (!Epi::AFTER_DRAIN) { E(acc, cur, wr, wc, fr, fq, pre); S.done(cur); }
        if (!has_next) break;
#pragma unroll
        for (int a = 0; a < 2; ++a)
#pragma unroll
            for (int b = 0; b < 2; ++b)
#pragma unroll
                for (int m = 0; m < 4; ++m)
#pragma unroll
                    for (int n = 0; n < 2; ++n) acc[a][b][m][n] = (f32x4){0.f, 0.f, 0.f, 0.f};
        cur = nxt; cA = nA; cB = nB; ++ui;
        if constexpr (ALIGN_EPI) { if (wr == 1) PG8_BAR; }
    }
    PG8_WAIT_V(0);
    if constexpr (!ALIGN_EPI) { if (wr == 0) PG8_BAR; }
    PG8_BAR;
    if constexpr (Epi::AFTER_DRAIN) { E.fused(acc, cur, wr, wc, fr, fq, lds, wid, lane); S.done(cur); }
#undef PG8_SA
#undef PG8_SB
#undef PG8_STAGE
#undef PG8_LDA
#undef PG8_LDB
#undef PG8_MMA
#undef PG8_WAIT_V
#undef PG8_WAIT_L
#undef PG8_BAR
#undef PG8_SCHED
}
}

constexpr int DM = 1024, NB = 8, SEQL = 8192, NCTX = 256, NLAT = NB * SEQL, MT = NLAT + NB * NCTX;
constexpr int FH = 2816, NPROJ = 2304, NMOD = 9, MODW = NMOD * DM, NKEY = SEQL + NCTX;
constexpr int NCHUNK = 132;
constexpr float EPS = 1e-6f;
constexpr int C_AQ = 0, C_AK = 128, C_AV = 256, C_AR = 512, C_GQ = 1024, C_GK = 1536, C_GV = 1664, C_WQ = 1792, C_WK = 2048, C_WV = 2176;
constexpr float QSCALE = 0.125f * 1.4426950408889634f;
constexpr float LOG2E = 1.4426950408889634f;

constexpr size_t MiB = 1u << 20;
constexpr size_t WS_CTLB = 65536, WS_SSQ = WS_CTLB, WS_MOD = 2 * MiB, WS_ROPE = 3 * MiB, WS_W = 6 * MiB;
constexpr size_t W_FFN_IN = (size_t)2 * FH * DM * 2, W_FFN_OUT = (size_t)DM * FH * 2, W_MIX_IN = (size_t)NPROJ * DM * 2, W_MIX_OUT = (size_t)DM * DM * 2;
constexpr size_t WO_F1I = 0, WO_F1O = WO_F1I + W_FFN_IN, WO_F2I = WO_F1O + W_FFN_OUT, WO_F2O = WO_F2I + W_FFN_IN, WO_MI = WO_F2O + W_FFN_OUT, WO_MO = WO_MI + W_MIX_IN, W_LAYER = WO_MO + W_MIX_OUT;
constexpr size_t WS_XC = WS_W + 2 * W_LAYER;
constexpr size_t WS_XN = WS_XC + (size_t)NB * NCTX * DM * 4;
constexpr size_t WS_HID = WS_XN + (size_t)MT * DM * 2;
constexpr size_t WS_VT = WS_HID + (size_t)MT * FH * 2;
constexpr size_t WS_G = WS_VT + (size_t)NB * 2 * 2 * 64 * NKEY * 2;
constexpr size_t WS_DS = WS_G + (size_t)MT * 256 * 4;
constexpr size_t WS_DEC = WS_DS + (size_t)32 * 2 * NCHUNK * 2048 * 4;
constexpr size_t WS_XB = WS_DEC + 2 * MiB;
constexpr size_t WS_SSQ_UNUSED = WS_XB + (size_t)MT * DM * 2;
static_assert(WS_SSQ + (size_t)6 * MT * 4 <= WS_MOD, "ctl map");
constexpr size_t WS_GM = WS_SSQ_UNUSED;
constexpr size_t WS_BIAS = WS_GM + 1 * MiB;
constexpr int BIASN = 2 * FH;
constexpr size_t WS_KT = WS_BIAS + 2 * MiB;
constexpr size_t WS_END = WS_KT + (size_t)NB * 4 * 132 * 4096 * 2;
static_assert(WS_END <= (size_t)1024 * MiB, "d_ws map");

typedef unsigned short bf16_t;
typedef short bf16x8 __attribute__((ext_vector_type(8)));
typedef short s16x4 __attribute__((ext_vector_type(4)));
typedef float f32x4 __attribute__((ext_vector_type(4)));
typedef float f32x16 __attribute__((ext_vector_type(16)));
typedef unsigned u32x4 __attribute__((ext_vector_type(4)));
typedef unsigned u32x2 __attribute__((ext_vector_type(2)));
#define LAS __attribute__((address_space(3)))

__device__ __forceinline__ unsigned f2bf(float f) { unsigned u = __builtin_bit_cast(unsigned, f); return (u + 0x7fffu + ((u >> 16) & 1u)) >> 16; }
__device__ __forceinline__ unsigned pk2(float lo, float hi) { return f2bf(lo) | (f2bf(hi) << 16); }
__device__ __forceinline__ float bf2f(unsigned short b) { return __builtin_bit_cast(float, (unsigned)b << 16); }
__device__ __forceinline__ float silu_f(float a) { return a * __builtin_amdgcn_rcpf(1.0f + __expf(-a)); }
__device__ __forceinline__ float wave_sum(float v) {
#pragma unroll
    for (int o = 1; o < 64; o <<= 1) v += __shfl_xor(v, o);
    return v;
}

struct Args {
    const float* in[25]; float* out; unsigned char* ws; int ph_lo, ph_hi;
};

namespace pg8 {
struct EpiSwiglu {
    static constexpr bool PERM = true, AFTER_DRAIN = false;
    struct Pre { float q[8]; };
    __device__ __forceinline__ void prefetch(const Unit& u, int wr, int fr, Pre& p) const {
        const int row0 = u.pm * BM + wr * 64 + fr;
#pragma unroll
        for (int j = 0; j < 8; ++j) p.q[j] = ssqp[row0 + (j >> 2) * HALF + (j & 3) * 16];
    }
    bf16_t* O; const float* ssqp; const float* bias;
    __device__ __forceinline__ void operator()(const f32x4 (&acc)[2][2][4][2], const Unit& u, int wr, int wc, int fr, int fq, const Pre& pre) const {
        const int row0 = u.pm * BM + wr * 64 + fr, col0 = u.pn * 128 + wc * 32 + 8 * fq;
        const int s = u.pm < (NLAT / BM) ? (u.pm >> 5) : 8;
        const float* bp = bias + (size_t)s * BIASN + u.pn * BM + wc * 32 + 8 * fq;
        const f32x4 ba0 = *(const f32x4*)bp, ba1 = *(const f32x4*)(bp + 4), bb0 = *(const f32x4*)(bp + HALF), bb1 = *(const f32x4*)(bp + HALF + 4);
#pragma unroll
        for (int ai = 0; ai < 2; ++ai)
#pragma unroll
            for (int m = 0; m < 4; ++m) {
                const int row = row0 + ai * HALF + m * 16;
                const float rstd = rsqrtf(pre.q[ai * 4 + m] * (1.0f / DM) + EPS);
                bf16_t* rowp = O + (size_t)row * FH + col0;
                const f32x4 a0 = acc[ai][0][m][0] * rstd + ba0, a1 = acc[ai][0][m][1] * rstd + ba1, b0 = acc[ai][1][m][0] * rstd + bb0, b1 = acc[ai][1][m][1] * rstd + bb1;
                u32x4 w;
                w.x = cvt_pk_bf16(silu_f(a0[0]) * b0[0], silu_f(a0[1]) * b0[1]); w.y = cvt_pk_bf16(silu_f(a0[2]) * b0[2], silu_f(a0[3]) * b0[3]);
                w.z = cvt_pk_bf16(silu_f(a1[0]) * b1[0], silu_f(a1[1]) * b1[1]); w.w = cvt_pk_bf16(silu_f(a1[2]) * b1[2], silu_f(a1[3]) * b1[3]);
                *(u32x4*)rowp = w;
            }
    }
};
struct EpiResid {
    static constexpr bool PERM = true, AFTER_DRAIN = false;
    struct Pre {}; __device__ __forceinline__ void prefetch(const Unit&, int, int, Pre&) const {}
    bf16_t* xb; float* fout; const float* gate;
    bf16_t* xnp; const float* gm; float* ssqp; float coef; int xn, fin;
    __device__ __forceinline__ void operator()(const f32x4 (&acc)[2][2][4][2], const Unit& u, int wr, int wc, int fr, int fq, const Pre&) const {
        const int s = u.pm < (NLAT / BM) ? (u.pm >> 5) : 8;
        const size_t rowbase = (size_t)u.pm * BM;
        const int col0 = u.pn * BM + wc * 32 + 8 * fq;
        f32x4 g[2][2], gmv[2][2];
#pragma unroll
        for (int bj = 0; bj < 2; ++bj)
#pragma unroll
            for (int n = 0; n < 2; ++n) { g[bj][n] = *(const f32x4*)(gate + (size_t)s * MODW + col0 + bj * HALF + n * 4) * coef;
                gmv[bj][n] = *(const f32x4*)(gm + (size_t)s * DM + col0 + bj * HALF + n * 4); }
        u32x4 cur[2], nxt[2]; int rcur, rnxt;
        rcur = wr * 64 + fr; asm volatile("" : "+v"(rcur));
#pragma unroll
        for (int bj = 0; bj < 2; ++bj) cur[bj] = *(const u32x4*)(xb + (rowbase + rcur) * DM + col0 + bj * HALF);
#pragma unroll
        for (int rg = 0; rg < 8; ++rg) {
            const int ai = rg >> 2, m = rg & 3;
            if (rg < 7) { rnxt = ((rg + 1) >> 2) * HALF + wr * 64 + ((rg + 1) & 3) * 16 + fr; asm volatile("" : "+v"(rnxt));
#pragma unroll
                for (int bj = 0; bj < 2; ++bj) nxt[bj] = *(const u32x4*)(xb + (rowbase + rnxt) * DM + col0 + bj * HALF); }
            const size_t off = (rowbase + rcur) * DM + col0;
            float ss = 0.f;
#pragma unroll
            for (int bj = 0; bj < 2; ++bj) {
                const u32x4 c = cur[bj];
                const f32x4 b0 = {__builtin_bit_cast(float, c.x << 16), __builtin_bit_cast(float, c.x & 0xffff0000u), __builtin_bit_cast(float, c.y << 16), __builtin_bit_cast(float, c.y & 0xffff0000u)};
                const f32x4 b1 = {__builtin_bit_cast(float, c.z << 16), __builtin_bit_cast(float, c.z & 0xffff0000u), __builtin_bit_cast(float, c.w << 16), __builtin_bit_cast(float, c.w & 0xffff0000u)};
                const f32x4 x0 = b0 + g[bj][0] * acc[ai][bj][m][0], x1 = b1 + g[bj][1] * acc[ai][bj][m][1];
                if (fin) { *(f32x4*)(fout + off + bj * HALF) = x0; *(f32x4*)(fout + off + bj * HALF + 4) = x1; }
                else { u32x4 w; w.x = cvt_pk_bf16(x0[0], x0[1]); w.y = cvt_pk_bf16(x0[2], x0[3]); w.z = cvt_pk_bf16(x1[0], x1[1]); w.w = cvt_pk_bf16(x1[2], x1[3]); *(u32x4*)(xb + off + bj * HALF) = w; }
                if (xn) { ss += ((x0[0] * x0[0] + x0[1] * x0[1]) + (x0[2] * x0[2] + x0[3] * x0[3])) + ((x1[0] * x1[0] + x1[1] * x1[1]) + (x1[2] * x1[2] + x1[3] * x1[3]));
                    const f32x4 y0 = x0 * gmv[bj][0], y1 = x1 * gmv[bj][1];
                    u32x4 w; w.x = cvt_pk_bf16(y0[0], y0[1]); w.y = cvt_pk_bf16(y0[2], y0[3]); w.z = cvt_pk_bf16(y1[0], y1[1]); w.w = cvt_pk_bf16(y1[2], y1[3]);
                    *(u32x4*)(xnp + off + bj * HALF) = w; }
            }
            if (xn) { ss += __shfl_xor(ss, 16); ss += __shfl_xor(ss, 32); if (fq == 0) __hip_atomic_fetch_add(ssqp + rowbase + rcur, ss, __ATOMIC_RELAXED, __HIP_MEMORY_SCOPE_AGENT); }
            if (rg < 7) { rcur = rnxt; cur[0] = nxt[0]; cur[1] = nxt[1]; }
        }
    }
};
struct EpiInproj {
    static constexpr bool PERM = true, AFTER_DRAIN = false;
    struct Pre {}; __device__ __forceinline__ void prefetch(const Unit&, int, int, Pre&) const {}
    bf16_t* P; float* G; const float* bgf; const float* bgb; const float* ssqp; const float* bias;
    __device__ __forceinline__ void operator()(const f32x4 (&acc)[2][2][4][2], const Unit& u, int wr, int wc, int fr, int fq, const Pre&) const {
        const int row0 = u.pm * BM + wr * 64 + fr;
        const int s = u.pm < (NLAT / BM) ? (u.pm >> 5) : 8;
        const float* bp = bias + (size_t)s * BIASN + u.pn * BM + wc * 32 + 8 * fq;
        f32x4 bv[2][2];
#pragma unroll
        for (int bj = 0; bj < 2; ++bj) { bv[bj][0] = *(const f32x4*)(bp + bj * HALF); bv[bj][1] = *(const f32x4*)(bp + bj * HALF + 4); }
        if (u.pn == 3) {
            const int c0 = wc * 32 + 8 * fq;
            bv[0][0] += *(const f32x4*)(bgf + c0); bv[0][1] += *(const f32x4*)(bgf + c0 + 4); bv[1][0] += *(const f32x4*)(bgb + c0); bv[1][1] += *(const f32x4*)(bgb + c0 + 4);
        }
#pragma unroll
        for (int ai = 0; ai < 2; ++ai)
#pragma unroll
            for (int m = 0; m < 4; ++m) {
                const int row = row0 + ai * HALF + m * 16;
                const float rstd = rsqrtf(ssqp[row] * (1.0f / DM) + EPS);
                if (u.pn == 3) {
                    const int c0 = wc * 32 + 8 * fq;
#pragma unroll
                    for (int bj = 0; bj < 2; ++bj) {
                        float* gp = G + (size_t)row * 256 + bj * HALF + c0;
                        const f32x4 v0 = acc[ai][bj][m][0] * rstd + bv[bj][0], v1 = acc[ai][bj][m][1] * rstd + bv[bj][1]; f32x4 o0, o1;
#pragma unroll
                        for (int i = 0; i < 4; ++i) {
                            o0[i] = (fminf(v0[i], 0.f) - __logf(1.0f + __expf(-fabsf(v0[i])))) * 0.0625f;
                            o1[i] = (fminf(v1[i], 0.f) - __logf(1.0f + __expf(-fabsf(v1[i])))) * 0.0625f;
                        }
                        *(f32x4*)gp = o0; *(f32x4*)(gp + 4) = o1;
                    }
                } else {
                    bf16_t* rowp = P + (size_t)row * NPROJ + u.pn * BM + wc * 32 + 8 * fq;
#pragma unroll
                    for (int bj = 0; bj < 2; ++bj) {
                        const f32x4 v0 = acc[ai][bj][m][0] * rstd + bv[bj][0], v1 = acc[ai][bj][m][1] * rstd + bv[bj][1];
                        u32x4 w; w.x = cvt_pk_bf16(v0[0], v0[1]); w.y = cvt_pk_bf16(v0[2], v0[3]); w.z = cvt_pk_bf16(v1[0], v1[1]); w.w = cvt_pk_bf16(v1[2], v1[3]);
                        *(u32x4*)(rowp + bj * HALF) = w;
                    }
                }
            }
    }
};
}

__device__ __forceinline__ void transpose_item(const float* W, int K, int N, bf16_t* WT, int k0, int n0, int drow0, LAS float* scr, int lane) {
#pragma unroll 8
    for (int i = 0; i < 32; ++i) { const int kk = 2 * i + (lane >> 5); scr[kk * 33 + (lane & 31)] = W[(size_t)(k0 + kk) * N + n0 + (lane & 31)]; }
    asm volatile("s_waitcnt lgkmcnt(0)" ::: "memory");
    const int c = lane & 7;
#pragma unroll
    for (int j = 0; j < 4; ++j) { const int n = (lane >> 3) + 8 * j; const LAS float* s = scr + (8 * c) * 33 + n;
        u32x4 o; o.x = pk2(s[0 * 33], s[1 * 33]); o.y = pk2(s[2 * 33], s[3 * 33]); o.z = pk2(s[4 * 33], s[5 * 33]); o.w = pk2(s[6 * 33], s[7 * 33]);
        *(u32x4*)(WT + (size_t)(drow0 + n) * K + k0 + 8 * c) = o; }
    asm volatile("s_waitcnt lgkmcnt(0)" ::: "memory");
}

__device__ __forceinline__ void prologue_phase(const Args& a, LAS unsigned char* lds) {
    const int tid = opaque_tid(), lane = tid & 63, wave = __builtin_amdgcn_readfirstlane(tid >> 6), G = gridDim.x, bidx = opaque_bid();
    const int gw = bidx * 8 + wave, NGW = G * 8;
    unsigned char* ws = a.ws;
    LAS float* scr = (LAS float*)(lds + wave * 16384);
    for (int l = 0; l < 2; ++l) {
        bf16_t* wl = (bf16_t*)(ws + WS_W + (size_t)l * W_LAYER);
        for (int f = 0; f < 2; ++f) {
            const float* W = a.in[f == 0 ? 7 : 23] + (size_t)l * DM * 2 * FH; bf16_t* WT = (bf16_t*)((unsigned char*)wl + (f == 0 ? WO_F1I : WO_F2I));
            const int nblk = 2 * FH / 32, nitem = (DM / 64) * nblk;
            for (int it = gw; it < nitem; it += NGW) { const int kb = it / nblk, nb = it % nblk, n0 = nb * 32;
                const int hf = n0 >= FH ? 1 : 0, np = n0 - hf * FH; const int drow0 = 256 * (np / 128) + 128 * hf + (np % 128);
                transpose_item(W, DM, 2 * FH, WT, kb * 64, n0, drow0, scr, lane); }
            const float* W2 = a.in[f == 0 ? 8 : 24] + (size_t)l * FH * DM; bf16_t* WT2 = (bf16_t*)((unsigned char*)wl + (f == 0 ? WO_F1O : WO_F2O));
            const int nblk2 = DM / 32, nitem2 = (FH / 64) * nblk2;
            for (int it = gw; it < nitem2; it += NGW) { const int kb = it / nblk2, nb = it % nblk2; transpose_item(W2, FH, DM, WT2, kb * 64, nb * 32, nb * 32, scr, lane); }
        }
        {
            const float* W = a.in[10] + (size_t)l * DM * 2080; bf16_t* WT = (bf16_t*)((unsigned char*)wl + WO_MI);
            const int nblk = 2080 / 32, nitem = (DM / 64) * nblk;
            for (int it = gw; it < nitem; it += NGW) { const int kb = it / nblk, nb = it % nblk, n0 = nb * 32; if (n0 == 768) continue;
                transpose_item(W, DM, 2080, WT, kb * 64, n0, n0 < 768 ? n0 : n0 + 224, scr, lane); }
            const float* wgf = a.in[12] + (size_t)l * 16 * 128; const float* wgb = a.in[14] + (size_t)l * 16 * 128;
            for (int idx = bidx * 512 + tid; idx < 256 * DM; idx += G * 512) { const int k = idx & (DM - 1), n = idx >> 10, dir = n >> 7, nn = n & 127;
                const float* wr = W + (size_t)k * 2080 + 768 + 16 * dir; const float* wg = (dir ? wgb : wgf) + nn; float s = 0.f;
#pragma unroll
                for (int r = 0; r < 16; ++r) s += wr[r] * wg[r * 128];
                WT[(size_t)(768 + n) * DM + k] = (bf16_t)f2bf(s); }
            const float* Wo = a.in[11] + (size_t)l * DM * DM; bf16_t* WTo = (bf16_t*)((unsigned char*)wl + WO_MO);
            const int nblk2 = DM / 32, nitem2 = (DM / 64) * nblk2;
            for (int it = gw; it < nitem2; it += NGW) { const int kb = it / nblk2, nb = it % nblk2; transpose_item(Wo, DM, DM, WTo, kb * 64, nb * 32, nb * 32, scr, lane); }
        }
    }
    {
        float* rope = (float*)(ws + WS_ROPE);
        for (int idx = bidx * 512 + tid; idx < SEQL * 32; idx += G * 512) { const int t = idx >> 5, i = idx & 31, fi = i & 15;
            const float inv = powf(10000.0f, -(float)fi / 16.0f); const float pos = (float)(i < 16 ? (t >> 6) : (t & 63)); const float ang = pos * inv;
            rope[t * 64 + i] = cosf(ang); rope[t * 64 + 32 + i] = sinf(ang); }
    }
    __syncthreads();
    {
        LAS float* sc = (LAS float*)lds;
        LAS float* red = (LAS float*)(lds + 9 * 1024 * 4);
        for (int i = tid; i < 9 * DM; i += 512) { const int s = i >> 10, k = i & (DM - 1); const float v = s < 8 ? a.in[1][s * DM + k] : a.in[3][k]; sc[i] = v / (1.0f + __expf(-v)); }
        __syncthreads();
        float* MOD = (float*)(ws + WS_MOD);
        const int nunit = 2 * (MODW / 64);
        for (int un = bidx; un < nunit; un += G) { const int l = un / (MODW / 64), cgp = un % (MODW / 64), col = cgp * 64 + lane;
            const float* mw = a.in[4] + (size_t)l * DM * MODW + col; float acc[9];
#pragma unroll
            for (int s = 0; s < 9; ++s) acc[s] = 0.f;
            const int kbeg = wave * 128;
#pragma unroll 8
            for (int k = kbeg; k < kbeg + 128; ++k) { const float w = mw[(size_t)k * MODW];
#pragma unroll
                for (int s = 0; s < 9; ++s) acc[s] += sc[s * DM + k] * w; }
#pragma unroll
            for (int s = 0; s < 9; ++s) red[(wave * 9 + s) * 64 + lane] = acc[s];
            __syncthreads();
            for (int i = tid; i < 9 * 64; i += 512) { const int s = i >> 6, ln = i & 63; float t = 0.f;
#pragma unroll
                for (int w = 0; w < 8; ++w) t += red[(w * 9 + s) * 64 + ln];
                MOD[((size_t)l * 9 + s) * MODW + cgp * 64 + ln] = t + a.in[5][(size_t)l * MODW + cgp * 64 + ln]; }
            __syncthreads();
        }
    }
}

__device__ __forceinline__ void norm_phase(const float* xlat, const float* xctx, bf16_t* xn, bf16_t* xb, const float* gain, const float* mod0, float* ssqp, int nrows) {
    const int tid = opaque_tid(), lane = tid & 63, wave = tid >> 6;
    const int gwv = opaque_bid() * 8 + wave, NGW = gridDim.x * 8;
    for (int row = gwv; row < nrows; row += NGW) {
        const bool lat = row < NLAT; const int s = lat ? (row >> 13) : 8;
        const float* xr = lat ? xlat + (size_t)row * DM : xctx + (size_t)(row - NLAT) * DM;
        const float* scl = mod0 + (size_t)s * MODW + DM;
        f32x4 v[4]; float ss = 0.f;
#pragma unroll
        for (int j = 0; j < 4; ++j) { v[j] = *(const f32x4*)(xr + 4 * (lane + 64 * j)); ss += (v[j][0] * v[j][0] + v[j][1] * v[j][1]) + (v[j][2] * v[j][2] + v[j][3] * v[j][3]); }
        ss = wave_sum(ss);
        if (lane == 0) ssqp[row] = ss;
#pragma unroll
        for (int j = 0; j < 4; ++j) { const int c = 4 * (lane + 64 * j);
            const f32x4 y = v[j] * (*(const f32x4*)(gain + c) * (*(const f32x4*)(scl + c) + 1.0f));
            u32x2 w; w.x = pk2(y[0], y[1]); w.y = pk2(y[2], y[3]);
            *(u32x2*)(xn + (size_t)row * DM + c) = w;
            u32x2 wx; wx.x = pk2(v[j][0], v[j][1]); wx.y = pk2(v[j][2], v[j][3]);
            *(u32x2*)(xb + (size_t)row * DM + c) = wx; }
    }
}

__device__ __forceinline__ void bias_phase(const Args& a) {
    const int tid = opaque_tid(), lane = tid & 63, wave = tid >> 6, bidx = opaque_bid(), G = gridDim.x;
    unsigned char* ws = a.ws; const float* MOD = (const float*)(ws + WS_MOD); float* GM = (float*)(ws + WS_GM); float* BIAS = (float*)(ws + WS_BIAS);
    for (int idx = bidx * 512 + tid; idx < 2 * 3 * 9 * DM; idx += G * 512) { const int c = idx & (DM - 1), s = (idx >> 10) % 9, w = (idx / (9 * DM)) % 3, l = idx / (27 * DM);
        const float* gn = a.in[w == 0 ? 6 : w == 1 ? 9 : 22] + l * DM;
        GM[idx] = gn[c] * (1.0f + MOD[((size_t)l * 9 + s) * MODW + (3 * w + 1) * DM + c]); }
    const int NR = 2 * FH + NPROJ + 2 * FH;
    for (int r = bidx * 8 + wave; r < 2 * NR; r += G * 8) { const int l = r / NR; int n = r % NR; int w = 0; if (n >= 2 * FH) { n -= 2 * FH; w = 1; if (n >= NPROJ) { n -= NPROJ; w = 2; } }
        const bf16_t* Wt = (const bf16_t*)(ws + WS_W + (size_t)l * W_LAYER + (w == 0 ? WO_F1I : w == 1 ? WO_MI : WO_F2I)) + (size_t)n * DM + 16 * lane;
        const bf16x8 w0 = *(const bf16x8*)Wt, w1 = *(const bf16x8*)(Wt + 8); float wf[16];
#pragma unroll
        for (int j = 0; j < 8; ++j) { wf[j] = bf2f((unsigned short)w0[j]); wf[8 + j] = bf2f((unsigned short)w1[j]); }
        for (int s = 0; s < 9; ++s) { const float* sh = MOD + ((size_t)l * 9 + s) * MODW + (3 * w) * DM + 16 * lane; float t = 0.f;
#pragma unroll
            for (int q = 0; q < 4; ++q) { const f32x4 x = *(const f32x4*)(sh + 4 * q); t += (x[0] * wf[4 * q] + x[1] * wf[4 * q + 1]) + (x[2] * wf[4 * q + 2] + x[3] * wf[4 * q + 3]); }
            t = wave_sum(t);
            if (lane == 0) BIAS[(((size_t)l * 3 + w) * 9 + s) * BIASN + n] = t; }
    }
}

__device__ __forceinline__ void prep_unit(int un, bf16_t* PROJ, bf16_t* VT, bf16_t* KT, const float* rope, const float* gqg, const float* gkg, const float* wqg, const float* wkg, LAS unsigned char* lds) {
    const int tid = opaque_tid(), lane = tid & 63, wave = tid >> 6;
    const int R0 = un * 64; const bool lat = R0 < NLAT;
    const int b = lat ? (R0 >> 13) : ((R0 - NLAT) >> 8); const int t0 = lat ? (R0 & (SEQL - 1)) : ((R0 - NLAT) & (NCTX - 1));
    const int kpos0 = lat ? t0 : SEQL + t0;
    const int hh = lane >> 2, sub = lane & 3;
    const int cbase = hh < 8 ? C_GQ + 64 * hh : hh < 10 ? C_GK + 64 * (hh - 8) : hh < 14 ? C_WQ + 64 * (hh - 10) : C_WK + 64 * (hh - 14);
    const float* gain = hh < 8 ? gqg : hh < 10 ? gkg : hh < 14 ? wqg : wkg;
    const bool isq = hh < 8 || (hh >= 10 && hh < 14);
    float g1[8], g2[8];
#pragma unroll
    for (int j = 0; j < 8; ++j) { g1[j] = gain[8 * sub + j]; g2[j] = gain[32 + 8 * sub + j]; }
#pragma unroll
    for (int rr = 0; rr < 8; ++rr) {
        const int r = wave * 8 + rr; bf16_t* p = PROJ + (size_t)(R0 + r) * NPROJ + cbase + 8 * sub;
        const bf16x8 a = *(const bf16x8*)p, c = *(const bf16x8*)(p + 32);
        float x1[8], x2[8]; float ss = 0.f;
#pragma unroll
        for (int j = 0; j < 8; ++j) { x1[j] = bf2f((unsigned short)a[j]); x2[j] = bf2f((unsigned short)c[j]); ss += x1[j] * x1[j] + x2[j] * x2[j]; }
        ss += __shfl_xor(ss, 1); ss += __shfl_xor(ss, 2);
        const float rstd = rsqrtf(ss * (1.0f / 64.0f) + EPS);
#pragma unroll
        for (int j = 0; j < 8; ++j) { x1[j] = x1[j] * rstd * g1[j]; x2[j] = x2[j] * rstd * g2[j]; }
        if (lat) { const float* rp = rope + (size_t)(t0 + r) * 64 + 8 * sub;
#pragma unroll
            for (int j = 0; j < 8; ++j) { const float cs = rp[j], sn = rp[32 + j]; const float y1 = x1[j] * cs - x2[j] * sn, y2 = x1[j] * sn + x2[j] * cs; x1[j] = y1; x2[j] = y2; } }
        const float qs = isq ? QSCALE : 1.0f;
        u32x4 w1, w2;
        w1.x = pk2(x1[0] * qs, x1[1] * qs); w1.y = pk2(x1[2] * qs, x1[3] * qs); w1.z = pk2(x1[4] * qs, x1[5] * qs); w1.w = pk2(x1[6] * qs, x1[7] * qs);
        w2.x = pk2(x2[0] * qs, x2[1] * qs); w2.y = pk2(x2[2] * qs, x2[3] * qs); w2.z = pk2(x2[4] * qs, x2[5] * qs); w2.w = pk2(x2[6] * qs, x2[7] * qs);
        if (isq) { *(u32x4*)p = w1; *(u32x4*)(p + 32) = w2; }
        else { const int ksel = hh >= 14 ? 1 : 0, kvh = ksel ? hh - 14 : hh - 8;
            bf16_t* kd = KT + ((size_t)((b * 2 + ksel) * 2 + kvh) * 132 + (kpos0 >> 6)) * 4096 + r * 64 + 8 * sub;
            *(u32x4*)kd = w1; *(u32x4*)(kd + 32) = w2; }
    }
    LAS bf16_t* vs = (LAS bf16_t*)lds;
    {
        const int r = tid >> 3, ch = tid & 7;
        const bf16_t* src = PROJ + (size_t)(R0 + r) * NPROJ + (ch < 4 ? C_GV + 32 * ch : C_WV + 32 * (ch - 4));
#pragma unroll
        for (int q = 0; q < 4; ++q) { const u32x4 v = *(const u32x4*)(src + 8 * q); LAS unsigned* d = (LAS unsigned*)(vs + r * 264 + ch * 32 + 8 * q); d[0] = v.x; d[1] = v.y; d[2] = v.z; d[3] = v.w; }
    }
    __syncthreads();
    {
        const int dc = tid >> 1, half = tid & 1;
        unsigned w[16];
#pragma unroll
        for (int i = 0; i < 16; ++i) { const unsigned lo = vs[(half * 32 + 2 * i) * 264 + dc], hi = vs[(half * 32 + 2 * i + 1) * 264 + dc]; w[i] = lo | (hi << 16); }
        bf16_t* dst = VT + ((size_t)(b * 4 + (dc >> 6)) * 132 + (kpos0 >> 6)) * 4096 + (dc & 63) * 64 + half * 32;
#pragma unroll
        for (int q = 0; q < 4; ++q) { u32x4 o; o.x = w[4 * q]; o.y = w[4 * q + 1]; o.z = w[4 * q + 2]; o.w = w[4 * q + 3]; *(u32x4*)(dst + 8 * q) = o; }
    }
    __syncthreads();
}

__device__ __forceinline__ int gla_row0(int b, int n) { return n < 4 ? NLAT + b * NCTX + 64 * n : b * SEQL + 64 * (n - 4); }
__device__ __forceinline__ int gla_posb(int n) { return n < 4 ? 3 - n : 135 - n; }

__device__ __forceinline__ void gla_g1_unit(int un, const bf16_t* PROJ, const float* G, float* DS, float* DEC, LAS unsigned char* lds) {
    const int tid = opaque_tid();
    const int bh = un / NCHUNK, n = un % NCHUNK, b = bh >> 2, h = bh & 3, R0 = gla_row0(b, n);
    LAS float* k = (LAS float*)lds;
    LAS float* v = k + 64 * 33;
    LAS float* bf = v + 64 * 64;
    LAS float* bb = bf + 64 * 33;
    LAS float* kf = bb + 64 * 33;
    LAS float* kb = kf + 64 * 33;
    for (int i = tid; i < 64 * 32; i += 512) { const int c = i >> 5, d = i & 31; const size_t row = (size_t)(R0 + c);
        k[c * 33 + d] = bf2f(PROJ[row * NPROJ + C_AK + 32 * h + d]);
        bf[c * 33 + d] = G[row * 256 + 32 * h + d]; bb[c * 33 + d] = G[row * 256 + 128 + 32 * h + d]; }
    for (int i = tid; i < 64 * 64; i += 512) { const int c = i >> 6, d = i & 63; v[i] = bf2f(PROJ[(size_t)(R0 + c) * NPROJ + C_AV + 64 * h + d]); }
    __syncthreads();
    if (tid < 32) { float s = 0.f; for (int c = 0; c < 64; ++c) { s += bf[c * 33 + tid]; bf[c * 33 + tid] = s; } }
    else if (tid < 64) { const int d = tid - 32; float s = 0.f; for (int c = 63; c >= 0; --c) { s += bb[c * 33 + d]; bb[c * 33 + d] = s; } }
    __syncthreads();
    for (int i = tid; i < 64 * 32; i += 512) { const int c = i >> 5, d = i & 31; const float kk = k[c * 33 + d];
        kf[c * 33 + d] = kk * __expf(bf[63 * 33 + d] - bf[c * 33 + d]); kb[c * 33 + d] = kk * __expf(bb[d] - bb[c * 33 + d]); }
    __syncthreads();
    {
        const int vv = tid & 63, dg = tid >> 6; float af[4] = {0.f, 0.f, 0.f, 0.f}, ab[4] = {0.f, 0.f, 0.f, 0.f};
        for (int c = 0; c < 64; ++c) { const float x = v[c * 64 + vv];
#pragma unroll
            for (int j = 0; j < 4; ++j) { af[j] += kf[c * 33 + dg * 4 + j] * x; ab[j] += kb[c * 33 + dg * 4 + j] * x; } }
        float* dsf = DS + ((size_t)(bh * 2 + 0) * NCHUNK + n) * 2048; float* dsb = DS + ((size_t)(bh * 2 + 1) * NCHUNK + gla_posb(n)) * 2048;
#pragma unroll
        for (int j = 0; j < 4; ++j) { dsf[(dg * 4 + j) * 64 + vv] = af[j]; dsb[(dg * 4 + j) * 64 + vv] = ab[j]; }
        if (tid < 32) DEC[((size_t)(bh * 2 + 0) * NCHUNK + n) * 32 + tid] = __expf(bf[63 * 33 + tid]);
        else if (tid < 64) DEC[((size_t)(bh * 2 + 1) * NCHUNK + gla_posb(n)) * 32 + (tid - 32)] = __expf(bb[tid - 32]);
    }
    __syncthreads();
}

__device__ __forceinline__ void gla_scan_chain(int ch, float* DS, const float* DEC) {
    const int tid = opaque_tid(), bd = ch >> 2, e = (ch & 3) * 512 + tid, d = e >> 6;
    float* ds = DS + (size_t)bd * NCHUNK * 2048 + e; const float* dec = DEC + (size_t)bd * NCHUNK * 32 + d;
    float S = 0.f;
    for (int p = 0; p < NCHUNK; p += 22) {
        float t[22], dc[22];
#pragma unroll
        for (int j = 0; j < 22; ++j) { t[j] = ds[(size_t)(p + j) * 2048]; dc[j] = dec[(p + j) * 32]; }
#pragma unroll
        for (int j = 0; j < 22; ++j) { ds[(size_t)(p + j) * 2048] = S; S = dc[j] * S + t[j]; }
    }
}

__device__ __forceinline__ void gla_g3_unit(int un, const bf16_t* PROJ, const float* G, const float* DS, const float* gain, bf16_t* MIX, LAS unsigned char* lds) {
    const int tid = opaque_tid(), lane = tid & 63;
    const int bh = un / NCHUNK, n = un % NCHUNK, b = bh >> 2, h = bh & 3, R0 = gla_row0(b, n);
    LAS float* q = (LAS float*)lds;
    LAS float* k = q + 64 * 33;
    LAS float* bf = k + 64 * 33;
    LAS float* bb = bf + 64 * 33;
    LAS float* qf = bb + 64 * 33;
    LAS float* kif = qf + 64 * 33;
    LAS float* qb = kif + 64 * 33;
    LAS float* kib = qb + 64 * 33;
    LAS float* v = kib + 64 * 33;
    LAS float* Sf = v + 64 * 64;
    LAS float* Sb = Sf + 32 * 64;
    LAS float* A = Sb + 32 * 64;
    for (int i = tid; i < 64 * 32; i += 512) { const int c = i >> 5, d = i & 31; const size_t row = (size_t)(R0 + c);
        q[c * 33 + d] = bf2f(PROJ[row * NPROJ + C_AQ + 32 * h + d]) * 0.17677669529663687f;
        k[c * 33 + d] = bf2f(PROJ[row * NPROJ + C_AK + 32 * h + d]);
        bf[c * 33 + d] = G[row * 256 + 32 * h + d]; bb[c * 33 + d] = G[row * 256 + 128 + 32 * h + d]; }
    for (int i = tid; i < 64 * 64; i += 512) { const int c = i >> 6, d = i & 63; v[i] = bf2f(PROJ[(size_t)(R0 + c) * NPROJ + C_AV + 64 * h + d]); }
    { const float* sf = DS + ((size_t)(bh * 2 + 0) * NCHUNK + n) * 2048; const float* sb = DS + ((size_t)(bh * 2 + 1) * NCHUNK + gla_posb(n)) * 2048;
      for (int i = tid; i < 2048; i += 512) { Sf[i] = sf[i]; Sb[i] = sb[i]; } }
    __syncthreads();
    if (tid < 32) { float s = 0.f; for (int c = 0; c < 64; ++c) { s += bf[c * 33 + tid]; bf[c * 33 + tid] = s; } }
    else if (tid < 64) { const int d = tid - 32; float s = 0.f; for (int c = 63; c >= 0; --c) { s += bb[c * 33 + d]; bb[c * 33 + d] = s; } }
    __syncthreads();
    for (int i = tid; i < 64 * 32; i += 512) { const int c = i >> 5, d = i & 31; const int o = c * 33 + d; const float ef = __expf(bf[o]), eb = __expf(bb[o]);
        qf[o] = q[o] * ef; kif[o] = k[o] / ef; qb[o] = q[o] * eb; kib[o] = k[o] / eb; }
    __syncthreads();
    {
        const int s = lane, cg0 = (tid >> 6) * 8;
#pragma unroll 1
        for (int j = 0; j < 8; ++j) { const int c = cg0 + j; float af = 0.f, ab = 0.f;
            if (s <= c) {
#pragma unroll 8
                for (int d = 0; d < 32; ++d) af += qf[c * 33 + d] * kif[s * 33 + d]; }
            if (s >= c) {
#pragma unroll 8
                for (int d = 0; d < 32; ++d) ab += qb[c * 33 + d] * kib[s * 33 + d]; }
            A[c * 65 + s] = af + ab; }
    }
    __syncthreads();
    {
        const int vv = lane, cg0 = (tid >> 6) * 8; const float gn = gain[vv];
#pragma unroll 1
        for (int j = 0; j < 8; ++j) { const int c = cg0 + j; float o = 0.f;
#pragma unroll 8
            for (int s = 0; s < 64; ++s) o += A[c * 65 + s] * v[s * 64 + vv];
#pragma unroll 8
            for (int d = 0; d < 32; ++d) o += qf[c * 33 + d] * Sf[d * 64 + vv] + qb[c * 33 + d] * Sb[d * 64 + vv];
            const float ms = wave_sum(o * o) * (1.0f / 64.0f);
            const float r = bf2f(PROJ[(size_t)(R0 + c) * NPROJ + C_AR + 64 * h + vv]);
            const float y = o * rsqrtf(ms + EPS) * gn * silu_f(r);
            MIX[(size_t)(R0 + c) * DM + 64 * h + vv] = (bf16_t)f2bf(y); }
    }
    __syncthreads();
}

struct AttnDesc { const bf16_t* Q; bf16_t* O; const bf16_t* Klat; const bf16_t* Kctx; const bf16_t* Vt; int nctx, nloc0, nloc, win, qpos0, has_sink; float sinkl2; };
constexpr int KSTR = 144, VSTR = 136, ABUF = 64 * KSTR + 64 * VSTR;
typedef float f32x2_t __attribute__((ext_vector_type(2))); typedef __bf16 bf16x2_t __attribute__((ext_vector_type(2)));
__device__ __forceinline__ unsigned cvtpk(float lo, float hi) { f32x2_t v = {lo, hi}; bf16x2_t b = __builtin_convertvector(v, bf16x2_t); return __builtin_bit_cast(unsigned, b); }
__device__ __forceinline__ float fadd_s(float a, float b) { float r; asm("v_add_f32_e32 %0, %1, %2" : "=v"(r) : "v"(a), "v"(b)); return r; }
__device__ __forceinline__ float max3f(float a, float b, float c) { return __builtin_fmaxf(__builtin_fmaxf(a, b), c); }
__device__ __forceinline__ int crow(int r, int hi) { return (r & 3) + 8 * (r >> 2) + 4 * hi; }

__device__ __forceinline__ void attn_unit(const AttnDesc& u, LAS unsigned char* lds) {
    const int tid = opaque_tid(), lane = tid & 63, r32 = lane & 31, hi = lane >> 5, wid = tid >> 6;
    const bf16_t* Qw = u.Q + (size_t)(wid * 32 + r32) * NPROJ;
    bf16x8 qr[4];
#pragma unroll
    for (int d0 = 0; d0 < 4; ++d0) qr[d0] = *(const bf16x8*)(Qw + d0 * 16 + hi * 8);
#pragma unroll
    for (int d0 = 0; d0 < 4; ++d0) asm volatile("" : "+v"(qr[d0]));
    f32x16 o0, o1, negm;
#pragma unroll
    for (int r = 0; r < 16; ++r) { o0[r] = 0.f; o1[r] = 0.f; negm[r] = 0.f; }
    float mhat = 0.f, lsum = 0.f;
    const int ntile = u.nctx + u.nloc;
    const int srow = tid >> 3, sch = tid & 7;
    u32x4 kreg, vreg;
#define ATT_LOAD(i) do { const int T_ = (i) < u.nctx ? 128 + (i) : u.nloc0 + ((i) - u.nctx); \
        kreg = *(const u32x4*)(u.Klat + (size_t)T_ * 4096 + srow * 64 + sch * 8); vreg = *(const u32x4*)(u.Vt + (size_t)T_ * 4096 + srow * 64 + sch * 8); } while (0)
#define ATT_STORE(buf) do { LAS unsigned char* kb_ = lds + (buf) * ABUF; *(LAS u32x4*)(kb_ + srow * KSTR + sch * 16) = kreg; \
        LAS u32x2* vd_ = (LAS u32x2*)(kb_ + 64 * KSTR + srow * VSTR + sch * 16); vd_[0] = (u32x2){vreg.x, vreg.y}; vd_[1] = (u32x2){vreg.z, vreg.w}; } while (0)
    ATT_LOAD(0); ATT_STORE(0);
    __syncthreads();
    for (int i = 0; i < ntile; ++i) {
        if (i + 1 < ntile) ATT_LOAD(i + 1);
        const LAS unsigned char* Kl = lds + (i & 1) * ABUF; const LAS unsigned char* Vl = Kl + 64 * KSTR;
        f32x16 p0, p1;
#pragma unroll
        for (int d0 = 0; d0 < 4; ++d0) {
            const bf16x8 k0 = *(const LAS bf16x8*)(Kl + r32 * KSTR + d0 * 32 + hi * 16), k1 = *(const LAS bf16x8*)(Kl + (r32 + 32) * KSTR + d0 * 32 + hi * 16);
            if (d0 == 0) { p0 = __builtin_amdgcn_mfma_f32_32x32x16_bf16(k0, qr[0], negm, 0, 0, 0); p1 = __builtin_amdgcn_mfma_f32_32x32x16_bf16(k1, qr[0], negm, 0, 0, 0); }
            else { p0 = __builtin_amdgcn_mfma_f32_32x32x16_bf16(k0, qr[d0], p0, 0, 0, 0); p1 = __builtin_amdgcn_mfma_f32_32x32x16_bf16(k1, qr[d0], p1, 0, 0, 0); }
        }
        const int T = i < u.nctx ? 128 + i : u.nloc0 + (i - u.nctx);
        if (u.win && T < 128) {
            const int qpos = u.qpos0 + wid * 32 + r32, kb = 64 * T - qpos;
#pragma unroll
            for (int r = 0; r < 16; ++r) { const int rel = kb + crow(r, hi); if (rel < -128 || rel > 128) p0[r] = -INFINITY; if (rel + 32 < -128 || rel + 32 > 128) p1[r] = -INFINITY; }
        }
        float rm = max3f(p0[0], p1[0], p0[1]), rm2 = max3f(p1[1], p0[2], p1[2]);
#pragma unroll
        for (int r = 3; r < 15; r += 2) { rm = max3f(rm, p0[r], p1[r]); rm2 = max3f(rm2, p0[r + 1], p1[r + 1]); }
        rm = max3f(rm, p0[15], p1[15]); rm = fmaxf(rm, rm2);
        rm = fmaxf(rm, __shfl_xor(rm, 32));
        if (i == 0) {
            mhat = rm;
#pragma unroll
            for (int r = 0; r < 16; ++r) { p0[r] -= rm; p1[r] -= rm; negm[r] = -mhat; }
        } else if (__any(rm > 8.0f)) {
            const float dl = fmaxf(rm, 0.f); mhat += dl; const float f = __builtin_amdgcn_exp2f(-dl); lsum *= f;
#pragma unroll
            for (int r = 0; r < 16; ++r) { p0[r] -= dl; p1[r] -= dl; negm[r] = -mhat; o0[r] *= f; o1[r] *= f; }
        }
        float ps = 0.f;
#pragma unroll
        for (int r = 0; r < 16; ++r) { p0[r] = __builtin_amdgcn_exp2f(p0[r]); p1[r] = __builtin_amdgcn_exp2f(p1[r]); ps += p0[r] + p1[r]; }
        lsum += ps;
        u32x4 pw[4];
        pw[0] = (u32x4){cvtpk(p0[0], p0[1]), cvtpk(p0[2], p0[3]), cvtpk(p0[4], p0[5]), cvtpk(p0[6], p0[7])};
        pw[1] = (u32x4){cvtpk(p0[8], p0[9]), cvtpk(p0[10], p0[11]), cvtpk(p0[12], p0[13]), cvtpk(p0[14], p0[15])};
        pw[2] = (u32x4){cvtpk(p1[0], p1[1]), cvtpk(p1[2], p1[3]), cvtpk(p1[4], p1[5]), cvtpk(p1[6], p1[7])};
        pw[3] = (u32x4){cvtpk(p1[8], p1[9]), cvtpk(p1[10], p1[11]), cvtpk(p1[12], p1[13]), cvtpk(p1[14], p1[15])};
#pragma unroll
        for (int ks = 0; ks < 4; ++ks) {
            const bf16x8 pa = __builtin_bit_cast(bf16x8, pw[ks]);
            const LAS unsigned char* vp = Vl + r32 * VSTR + (16 * ks + 4 * hi) * 2;
            const s16x4 a0 = *(const LAS s16x4*)vp, a1 = *(const LAS s16x4*)(vp + 16);
            const s16x4 c0 = *(const LAS s16x4*)(vp + 32 * VSTR), c1 = *(const LAS s16x4*)(vp + 32 * VSTR + 16);
            const bf16x8 v0 = (bf16x8){a0[0], a0[1], a0[2], a0[3], a1[0], a1[1], a1[2], a1[3]}, v1 = (bf16x8){c0[0], c0[1], c0[2], c0[3], c1[0], c1[1], c1[2], c1[3]};
            o0 = __builtin_amdgcn_mfma_f32_32x32x16_bf16(v0, pa, o0, 0, 0, 0);
            o1 = __builtin_amdgcn_mfma_f32_32x32x16_bf16(v1, pa, o1, 0, 0, 0);
        }
        if (i + 1 < ntile) ATT_STORE((i + 1) & 1);
        __syncthreads();
    }
#undef ATT_LOAD
#undef ATT_STORE
    float lt = lsum + __shfl_xor(lsum, 32);
    if (u.has_sink) lt += __builtin_amdgcn_exp2f(u.sinkl2 - mhat);
    const float inv = 1.0f / lt;
    bf16_t* Ow = u.O + (size_t)(wid * 32 + r32) * DM;
#pragma unroll
    for (int g = 0; g < 4; ++g) {
        u32x2 w0, w1;
        w0.x = pk2(o0[4 * g] * inv, o0[4 * g + 1] * inv); w0.y = pk2(o0[4 * g + 2] * inv, o0[4 * g + 3] * inv);
        w1.x = pk2(o1[4 * g] * inv, o1[4 * g + 1] * inv); w1.y = pk2(o1[4 * g + 2] * inv, o1[4 * g + 3] * inv);
        *(u32x2*)(Ow + 8 * g + 4 * hi) = w0; *(u32x2*)(Ow + 32 + 8 * g + 4 * hi) = w1;
    }
}


constexpr int GL_SLOT = 24576, GL_QB = 0, GL_KB = 5120, GL_VT = 10240, GL_ST = 18944;
__device__ __forceinline__ float wave_scan_incl(float v, int lane) {
#pragma unroll
    for (int o = 1; o < 64; o <<= 1) { const float t = __shfl_up(v, o); v = lane >= o ? v + t : v; }
    return v;
}
__device__ __forceinline__ bf16x8 lds_rd2x64(const LAS unsigned char* p) { const s16x4 a = *(const LAS s16x4*)p, b = *(const LAS s16x4*)(p + 8); return (bf16x8){a[0], a[1], a[2], a[3], b[0], b[1], b[2], b[3]}; }

__device__ __forceinline__ void gla_g1_mfma(int grp, const bf16_t* PROJ, const float* G, float* DS, float* DEC, LAS unsigned char* lds) {
    const int tid = opaque_tid(), lane = tid & 63, wave = tid >> 6, slot = wave >> 1, m = wave & 1, r32 = lane & 31, hi = lane >> 5;
    const int bh = grp / 33, n = (grp % 33) * 4 + slot, b = bh >> 2, h = bh & 3, R0 = gla_row0(b, n), posb = gla_posb(n);
    LAS unsigned char* sl = lds + slot * GL_SLOT;
    const bf16_t* pr = PROJ + (size_t)(R0 + lane) * NPROJ; const float* gr = G + (size_t)(R0 + lane) * 256 + 32 * h + 16 * m;
    const bf16x8 kv0 = *(const bf16x8*)(pr + C_AK + 32 * h + 16 * m), kv1 = *(const bf16x8*)(pr + C_AK + 32 * h + 16 * m + 8);
    float gf[16], gb[16], kk[16];
#pragma unroll
    for (int i = 0; i < 4; ++i) { const f32x4 a = *(const f32x4*)(gr + 4 * i), c = *(const f32x4*)(gr + 128 + 4 * i);
#pragma unroll
        for (int j = 0; j < 4; ++j) { gf[4 * i + j] = a[j]; gb[4 * i + j] = c[j]; } }
#pragma unroll
    for (int j = 0; j < 8; ++j) { kk[j] = bf2f((unsigned short)kv0[j]); kk[8 + j] = bf2f((unsigned short)kv1[j]); }
#pragma unroll
    for (int i = 0; i < 4; ++i) { const bf16x8 v8 = *(const bf16x8*)(pr + C_AV + 64 * h + 32 * m + 8 * i);
#pragma unroll
        for (int j = 0; j < 8; ++j) *(LAS bf16_t*)(sl + GL_VT + (32 * m + 8 * i + j) * 136 + 2 * lane) = (bf16_t)v8[j]; }
#pragma unroll
    for (int i = 0; i < 16; ++i) {
        const float bf = wave_scan_incl(gf[i], lane); const float t = wave_scan_incl(gb[i], lane); const float bb = __shfl(t, 63) - t + gb[i];
        const float gamf = __shfl(bf, 63), gamb = __shfl(bb, 0);
        *(LAS bf16_t*)(sl + GL_QB + (16 * m + i) * 136 + 2 * lane) = (bf16_t)f2bf(kk[i] * __expf(gamf - bf));
        *(LAS bf16_t*)(sl + GL_KB + (16 * m + i) * 136 + 2 * lane) = (bf16_t)f2bf(kk[i] * __expf(gamb - bb));
        if (lane == 63) DEC[((size_t)(bh * 2 + 0) * NCHUNK + n) * 32 + 16 * m + i] = __expf(bf);
        if (lane == 0) DEC[((size_t)(bh * 2 + 1) * NCHUNK + posb) * 32 + 16 * m + i] = __expf(bb);
    }
    __syncthreads();
    {
        const LAS unsigned char* KT = sl + (m == 0 ? GL_QB : GL_KB);
        f32x16 acc0, acc1;
#pragma unroll
        for (int r = 0; r < 16; ++r) { acc0[r] = 0.f; acc1[r] = 0.f; }
#pragma unroll
        for (int ks = 0; ks < 4; ++ks) {
            const bf16x8 bfr = lds_rd2x64(KT + r32 * 136 + (16 * ks + 8 * hi) * 2);
            const bf16x8 a0 = lds_rd2x64(sl + GL_VT + r32 * 136 + (16 * ks + 8 * hi) * 2), a1 = lds_rd2x64(sl + GL_VT + (32 + r32) * 136 + (16 * ks + 8 * hi) * 2);
            acc0 = __builtin_amdgcn_mfma_f32_32x32x16_bf16(a0, bfr, acc0, 0, 0, 0); acc1 = __builtin_amdgcn_mfma_f32_32x32x16_bf16(a1, bfr, acc1, 0, 0, 0);
        }
        float* dst = DS + ((size_t)(bh * 2 + m) * NCHUNK + (m == 0 ? n : posb)) * 2048 + r32 * 64;
#pragma unroll
        for (int g = 0; g < 4; ++g) {
            *(f32x4*)(dst + 8 * g + 4 * hi) = (f32x4){acc0[4 * g], acc0[4 * g + 1], acc0[4 * g + 2], acc0[4 * g + 3]};
            *(f32x4*)(dst + 32 + 8 * g + 4 * hi) = (f32x4){acc1[4 * g], acc1[4 * g + 1], acc1[4 * g + 2], acc1[4 * g + 3]};
        }
    }
    __syncthreads();
}

__device__ __forceinline__ void gla_g3_mfma(int grp, const bf16_t* PROJ, const float* G, const float* DS, const float* gain, bf16_t* MIX, LAS unsigned char* lds) {
    const int tid = opaque_tid(), lane = tid & 63, wave = tid >> 6, slot = wave >> 1, m = wave & 1, r32 = lane & 31, hi = lane >> 5;
    const int bh = grp / 33, n = (grp % 33) * 4 + slot, b = bh >> 2, h = bh & 3, R0 = gla_row0(b, n), posb = gla_posb(n);
    LAS unsigned char* sl = lds + slot * GL_SLOT;
    const bf16_t* pr = PROJ + (size_t)(R0 + lane) * NPROJ; const float* gr = G + (size_t)(R0 + lane) * 256 + 32 * h + 16 * m;
    const bf16x8 qv0 = *(const bf16x8*)(pr + C_AQ + 32 * h + 16 * m), qv1 = *(const bf16x8*)(pr + C_AQ + 32 * h + 16 * m + 8);
    const bf16x8 kv0 = *(const bf16x8*)(pr + C_AK + 32 * h + 16 * m), kv1 = *(const bf16x8*)(pr + C_AK + 32 * h + 16 * m + 8);
    s16x4 rga[4], rgb[4];
    { const bf16_t* rp0 = PROJ + (size_t)(R0 + 32 * m + r32) * NPROJ + C_AR + 64 * h;
#pragma unroll
      for (int g = 0; g < 4; ++g) { rga[g] = *(const s16x4*)(rp0 + 8 * g + 4 * hi); rgb[g] = *(const s16x4*)(rp0 + 32 + 8 * g + 4 * hi); } }
    float bf[16], bb[16], qq[16], kk[16];
#pragma unroll
    for (int i = 0; i < 4; ++i) { const f32x4 a = *(const f32x4*)(gr + 4 * i), c = *(const f32x4*)(gr + 128 + 4 * i);
#pragma unroll
        for (int j = 0; j < 4; ++j) { bf[4 * i + j] = a[j]; bb[4 * i + j] = c[j]; } }
#pragma unroll
    for (int j = 0; j < 8; ++j) { qq[j] = bf2f((unsigned short)qv0[j]) * 0.17677669529663687f; qq[8 + j] = bf2f((unsigned short)qv1[j]) * 0.17677669529663687f; kk[j] = bf2f((unsigned short)kv0[j]); kk[8 + j] = bf2f((unsigned short)kv1[j]); }
#pragma unroll
    for (int i = 0; i < 4; ++i) { const bf16x8 v8 = *(const bf16x8*)(pr + C_AV + 64 * h + 32 * m + 8 * i);
#pragma unroll
        for (int j = 0; j < 8; ++j) *(LAS bf16_t*)(sl + GL_VT + (32 * m + 8 * i + j) * 136 + 2 * lane) = (bf16_t)v8[j]; }
    const float* sfp = DS + ((size_t)(bh * 2 + 0) * NCHUNK + n) * 2048 + (16 * m) * 64 + lane; const float* sbp = DS + ((size_t)(bh * 2 + 1) * NCHUNK + posb) * 2048 + (16 * m) * 64 + lane;
    float sfv[16], sbv[16];
#pragma unroll
    for (int i = 0; i < 16; ++i) { sfv[i] = sfp[i * 64]; sbv[i] = sbp[i * 64]; }
#pragma unroll
    for (int i = 0; i < 16; ++i) { bf[i] = wave_scan_incl(bf[i], lane); const float g0 = bb[i]; const float t = wave_scan_incl(g0, lane); bb[i] = __shfl(t, 63) - t + g0; }
    {
        unsigned wq[8], wk[8], wsx[8];
#pragma unroll
        for (int i = 0; i < 8; ++i) { const float e0 = __expf(bf[2 * i]), e1 = __expf(bf[2 * i + 1]), i0 = __expf(-bf[2 * i]), i1 = __expf(-bf[2 * i + 1]);
            wq[i] = cvtpk(qq[2 * i] * e0, qq[2 * i + 1] * e1); wk[i] = cvtpk(kk[2 * i] * i0, kk[2 * i + 1] * i1); wsx[i] = cvtpk(sfv[2 * i], sfv[2 * i + 1]); }
        LAS u32x4* dq = (LAS u32x4*)(sl + GL_QB + lane * 80 + 32 * m); dq[0] = (u32x4){wq[0], wq[1], wq[2], wq[3]}; dq[1] = (u32x4){wq[4], wq[5], wq[6], wq[7]};
        LAS u32x4* dk = (LAS u32x4*)(sl + GL_KB + lane * 80 + 32 * m); dk[0] = (u32x4){wk[0], wk[1], wk[2], wk[3]}; dk[1] = (u32x4){wk[4], wk[5], wk[6], wk[7]};
        LAS u32x4* dsx = (LAS u32x4*)(sl + GL_ST + lane * 80 + 32 * m); dsx[0] = (u32x4){wsx[0], wsx[1], wsx[2], wsx[3]}; dsx[1] = (u32x4){wsx[4], wsx[5], wsx[6], wsx[7]};
    }
    __syncthreads();
    f32x16 P0, P1, O0, O1;
#pragma unroll
    for (int r = 0; r < 16; ++r) { P0[r] = 0.f; P1[r] = 0.f; O0[r] = 0.f; O1[r] = 0.f; }
    const int cloc = 32 * m + r32;
    {
        bf16x8 qfr[2];
#pragma unroll
        for (int kq = 0; kq < 2; ++kq) qfr[kq] = *(const LAS bf16x8*)(sl + GL_QB + cloc * 80 + kq * 32 + hi * 16);
#pragma unroll
        for (int kq = 0; kq < 2; ++kq) {
            P0 = __builtin_amdgcn_mfma_f32_32x32x16_bf16(*(const LAS bf16x8*)(sl + GL_KB + r32 * 80 + kq * 32 + hi * 16), qfr[kq], P0, 0, 0, 0);
            P1 = __builtin_amdgcn_mfma_f32_32x32x16_bf16(*(const LAS bf16x8*)(sl + GL_KB + (32 + r32) * 80 + kq * 32 + hi * 16), qfr[kq], P1, 0, 0, 0);
            O0 = __builtin_amdgcn_mfma_f32_32x32x16_bf16(*(const LAS bf16x8*)(sl + GL_ST + r32 * 80 + kq * 32 + hi * 16), qfr[kq], O0, 0, 0, 0);
            O1 = __builtin_amdgcn_mfma_f32_32x32x16_bf16(*(const LAS bf16x8*)(sl + GL_ST + (32 + r32) * 80 + kq * 32 + hi * 16), qfr[kq], O1, 0, 0, 0);
        }
#pragma unroll
        for (int r = 0; r < 16; ++r) { const int s0 = crow(r, hi); if (s0 > cloc) P0[r] = 0.f; if (s0 + 32 > cloc) P1[r] = 0.f; }
    }
    __syncthreads();
    {
        unsigned wq[8], wk[8], wsx[8];
#pragma unroll
        for (int i = 0; i < 8; ++i) { const float e0 = __expf(bb[2 * i]), e1 = __expf(bb[2 * i + 1]), i0 = __expf(-bb[2 * i]), i1 = __expf(-bb[2 * i + 1]);
            wq[i] = cvtpk(qq[2 * i] * e0, qq[2 * i + 1] * e1); wk[i] = cvtpk(kk[2 * i] * i0, kk[2 * i + 1] * i1); wsx[i] = cvtpk(sbv[2 * i], sbv[2 * i + 1]); }
        LAS u32x4* dq = (LAS u32x4*)(sl + GL_QB + lane * 80 + 32 * m); dq[0] = (u32x4){wq[0], wq[1], wq[2], wq[3]}; dq[1] = (u32x4){wq[4], wq[5], wq[6], wq[7]};
        LAS u32x4* dk = (LAS u32x4*)(sl + GL_KB + lane * 80 + 32 * m); dk[0] = (u32x4){wk[0], wk[1], wk[2], wk[3]}; dk[1] = (u32x4){wk[4], wk[5], wk[6], wk[7]};
        LAS u32x4* dsx = (LAS u32x4*)(sl + GL_ST + lane * 80 + 32 * m); dsx[0] = (u32x4){wsx[0], wsx[1], wsx[2], wsx[3]}; dsx[1] = (u32x4){wsx[4], wsx[5], wsx[6], wsx[7]};
    }
    __syncthreads();
    {
        f32x16 B0, B1;
#pragma unroll
        for (int r = 0; r < 16; ++r) { B0[r] = 0.f; B1[r] = 0.f; }
        bf16x8 qfr[2];
#pragma unroll
        for (int kq = 0; kq < 2; ++kq) qfr[kq] = *(const LAS bf16x8*)(sl + GL_QB + cloc * 80 + kq * 32 + hi * 16);
#pragma unroll
        for (int kq = 0; kq < 2; ++kq) {
            B0 = __builtin_amdgcn_mfma_f32_32x32x16_bf16(*(const LAS bf16x8*)(sl + GL_KB + r32 * 80 + kq * 32 + hi * 16), qfr[kq], B0, 0, 0, 0);
            B1 = __builtin_amdgcn_mfma_f32_32x32x16_bf16(*(const LAS bf16x8*)(sl + GL_KB + (32 + r32) * 80 + kq * 32 + hi * 16), qfr[kq], B1, 0, 0, 0);
            O0 = __builtin_amdgcn_mfma_f32_32x32x16_bf16(*(const LAS bf16x8*)(sl + GL_ST + r32 * 80 + kq * 32 + hi * 16), qfr[kq], O0, 0, 0, 0);
            O1 = __builtin_amdgcn_mfma_f32_32x32x16_bf16(*(const LAS bf16x8*)(sl + GL_ST + (32 + r32) * 80 + kq * 32 + hi * 16), qfr[kq], O1, 0, 0, 0);
        }
#pragma unroll
        for (int r = 0; r < 16; ++r) { const int s0 = crow(r, hi); if (s0 >= cloc) P0[r] += B0[r]; if (s0 + 32 >= cloc) P1[r] += B1[r]; }
    }
    {
        u32x4 pw[4];
        pw[0] = (u32x4){cvtpk(P0[0], P0[1]), cvtpk(P0[2], P0[3]), cvtpk(P0[4], P0[5]), cvtpk(P0[6], P0[7])};
        pw[1] = (u32x4){cvtpk(P0[8], P0[9]), cvtpk(P0[10], P0[11]), cvtpk(P0[12], P0[13]), cvtpk(P0[14], P0[15])};
        pw[2] = (u32x4){cvtpk(P1[0], P1[1]), cvtpk(P1[2], P1[3]), cvtpk(P1[4], P1[5]), cvtpk(P1[6], P1[7])};
        pw[3] = (u32x4){cvtpk(P1[8], P1[9]), cvtpk(P1[10], P1[11]), cvtpk(P1[12], P1[13]), cvtpk(P1[14], P1[15])};
#pragma unroll
        for (int ks = 0; ks < 4; ++ks) {
            const bf16x8 pa = __builtin_bit_cast(bf16x8, pw[ks]);
            const LAS unsigned char* vp = sl + GL_VT + r32 * 136 + (16 * ks + 4 * hi) * 2;
            const s16x4 a0 = *(const LAS s16x4*)vp, a1 = *(const LAS s16x4*)(vp + 16), c0 = *(const LAS s16x4*)(vp + 32 * 136), c1 = *(const LAS s16x4*)(vp + 32 * 136 + 16);
            O0 = __builtin_amdgcn_mfma_f32_32x32x16_bf16((bf16x8){a0[0], a0[1], a0[2], a0[3], a1[0], a1[1], a1[2], a1[3]}, pa, O0, 0, 0, 0);
            O1 = __builtin_amdgcn_mfma_f32_32x32x16_bf16((bf16x8){c0[0], c0[1], c0[2], c0[3], c1[0], c1[1], c1[2], c1[3]}, pa, O1, 0, 0, 0);
        }
    }
    {
        float ss = 0.f;
#pragma unroll
        for (int r = 0; r < 16; ++r) ss += O0[r] * O0[r] + O1[r] * O1[r];
        ss += __shfl_xor(ss, 32);
        const float rstd = rsqrtf(ss * (1.0f / 64.0f) + EPS);
        const size_t rowc = (size_t)(R0 + cloc);
        const bf16_t* rp = PROJ + rowc * NPROJ + C_AR + 64 * h; bf16_t* op = MIX + rowc * DM + 64 * h;
#pragma unroll
        for (int g = 0; g < 4; ++g) {
            const int v0 = 8 * g + 4 * hi;
            const s16x4 ra = rga[g], rb = rgb[g];
            const f32x4 ga = *(const f32x4*)(gain + v0), gbn = *(const f32x4*)(gain + 32 + v0);
            float ya[4], yb[4];
#pragma unroll
            for (int j = 0; j < 4; ++j) { ya[j] = O0[4 * g + j] * rstd * ga[j] * silu_f(bf2f((unsigned short)ra[j])); yb[j] = O1[4 * g + j] * rstd * gbn[j] * silu_f(bf2f((unsigned short)rb[j])); }
            *(u32x2*)(op + v0) = (u32x2){cvtpk(ya[0], ya[1]), cvtpk(ya[2], ya[3])};
            *(u32x2*)(op + 32 + v0) = (u32x2){cvtpk(yb[0], yb[1]), cvtpk(yb[2], yb[3])};
        }
    }
    __syncthreads();
}


struct Attn2Desc { const bf16_t* Q; bf16_t* O; const bf16_t* Klat; const bf16_t* Kctx; const bf16_t* Vt; int nctx, nloc0, nloc, win, qpos0, has_sink, rot; float sinkA, sinkB; };
__device__ __forceinline__ void attn2_tile(const Attn2Desc& u, const LAS unsigned char* Kl, int T, int qlo, int qpos, int r32, int hi,
                                           const bf16x8 (&qA)[4], const bf16x8 (&qB)[4], f32x16& oA0, f32x16& oA1, f32x16& oB0, f32x16& oB1, float& lA, float& lB) {
        const bool masked = u.win && T < 128;
        const bool active = !masked || (64 * T <= qlo + 31 + 128 && 64 * T + 63 >= qlo - 128);
        if (active) {
            const LAS unsigned char* Vl = Kl + 64 * KSTR;
            f32x16 pA0, pA1, pB0, pB1;
#pragma unroll
            for (int r = 0; r < 16; ++r) { pA0[r] = 0.f; pA1[r] = 0.f; pB0[r] = 0.f; pB1[r] = 0.f; }
#pragma unroll
            for (int d0 = 0; d0 < 4; ++d0) {
                const bf16x8 k0 = *(const LAS bf16x8*)(Kl + r32 * KSTR + d0 * 32 + hi * 16), k1 = *(const LAS bf16x8*)(Kl + (r32 + 32) * KSTR + d0 * 32 + hi * 16);
                pA0 = __builtin_amdgcn_mfma_f32_32x32x16_bf16(k0, qA[d0], pA0, 0, 0, 0); pA1 = __builtin_amdgcn_mfma_f32_32x32x16_bf16(k1, qA[d0], pA1, 0, 0, 0);
                pB0 = __builtin_amdgcn_mfma_f32_32x32x16_bf16(k0, qB[d0], pB0, 0, 0, 0); pB1 = __builtin_amdgcn_mfma_f32_32x32x16_bf16(k1, qB[d0], pB1, 0, 0, 0);
            }
            if (masked) {
                asm volatile("" ::: "memory");
                const int kb = 64 * T - qpos;
#pragma unroll
                for (int r = 0; r < 16; ++r) { const int rel = kb + crow(r, hi);
                    if (rel < -128 || rel > 128) { pA0[r] = -INFINITY; pB0[r] = -INFINITY; }
                    if (rel + 32 < -128 || rel + 32 > 128) { pA1[r] = -INFINITY; pB1[r] = -INFINITY; } }
            }
            bf16x8 vf0[4], vf1[4];
#pragma unroll
            for (int ks = 0; ks < 4; ++ks) {
                const LAS unsigned char* vp = Vl + r32 * VSTR + (16 * ks + 4 * hi) * 2;
                const s16x4 a0 = *(const LAS s16x4*)vp, a1 = *(const LAS s16x4*)(vp + 16);
                const s16x4 c0 = *(const LAS s16x4*)(vp + 32 * VSTR), c1 = *(const LAS s16x4*)(vp + 32 * VSTR + 16);
                vf0[ks] = (bf16x8){a0[0], a0[1], a0[2], a0[3], a1[0], a1[1], a1[2], a1[3]}; vf1[ks] = (bf16x8){c0[0], c0[1], c0[2], c0[3], c1[0], c1[1], c1[2], c1[3]};
            }
            u32x4 pwA[4], pwB[4];
            {
                float ps = 0.f;
#pragma unroll
                for (int r = 0; r < 16; ++r) { pA0[r] = __builtin_amdgcn_exp2f(pA0[r]); pA1[r] = __builtin_amdgcn_exp2f(pA1[r]); ps += pA0[r]; asm("" : "+v"(ps)); lA += pA1[r]; asm("" : "+v"(lA)); }
                lA += ps;
                pwA[0] = (u32x4){cvtpk(pA0[0], pA0[1]), cvtpk(pA0[2], pA0[3]), cvtpk(pA0[4], pA0[5]), cvtpk(pA0[6], pA0[7])};
                pwA[1] = (u32x4){cvtpk(pA0[8], pA0[9]), cvtpk(pA0[10], pA0[11]), cvtpk(pA0[12], pA0[13]), cvtpk(pA0[14], pA0[15])};
                pwA[2] = (u32x4){cvtpk(pA1[0], pA1[1]), cvtpk(pA1[2], pA1[3]), cvtpk(pA1[4], pA1[5]), cvtpk(pA1[6], pA1[7])};
                pwA[3] = (u32x4){cvtpk(pA1[8], pA1[9]), cvtpk(pA1[10], pA1[11]), cvtpk(pA1[12], pA1[13]), cvtpk(pA1[14], pA1[15])};
            }
            {
                float ps = 0.f;
#pragma unroll
                for (int r = 0; r < 16; ++r) { pB0[r] = __builtin_amdgcn_exp2f(pB0[r]); pB1[r] = __builtin_amdgcn_exp2f(pB1[r]); ps += pB0[r]; asm("" : "+v"(ps)); lB += pB1[r]; asm("" : "+v"(lB)); }
                lB += ps;
                pwB[0] = (u32x4){cvtpk(pB0[0], pB0[1]), cvtpk(pB0[2], pB0[3]), cvtpk(pB0[4], pB0[5]), cvtpk(pB0[6], pB0[7])};
                pwB[1] = (u32x4){cvtpk(pB0[8], pB0[9]), cvtpk(pB0[10], pB0[11]), cvtpk(pB0[12], pB0[13]), cvtpk(pB0[14], pB0[15])};
                pwB[2] = (u32x4){cvtpk(pB1[0], pB1[1]), cvtpk(pB1[2], pB1[3]), cvtpk(pB1[4], pB1[5]), cvtpk(pB1[6], pB1[7])};
                pwB[3] = (u32x4){cvtpk(pB1[8], pB1[9]), cvtpk(pB1[10], pB1[11]), cvtpk(pB1[12], pB1[13]), cvtpk(pB1[14], pB1[15])};
            }
#pragma unroll
            for (int ks = 0; ks < 4; ++ks) {
                const bf16x8 paA = __builtin_bit_cast(bf16x8, pwA[ks]), paB = __builtin_bit_cast(bf16x8, pwB[ks]);
                oA0 = __builtin_amdgcn_mfma_f32_32x32x16_bf16(vf0[ks], paA, oA0, 0, 0, 0); oA1 = __builtin_amdgcn_mfma_f32_32x32x16_bf16(vf1[ks], paA, oA1, 0, 0, 0);
                oB0 = __builtin_amdgcn_mfma_f32_32x32x16_bf16(vf0[ks], paB, oB0, 0, 0, 0); oB1 = __builtin_amdgcn_mfma_f32_32x32x16_bf16(vf1[ks], paB, oB1, 0, 0, 0);
            }
        }
}
__device__ __forceinline__ void attn2_unit(const Attn2Desc& u, LAS unsigned char* lds) {
    const int tid = opaque_tid(), lane = tid & 63, r32 = lane & 31, hi = lane >> 5, wid = tid >> 6;
    const bf16_t* Qw = u.Q + (size_t)(wid * 32 + r32) * NPROJ;
    bf16x8 qA[4], qB[4];
#pragma unroll
    for (int d0 = 0; d0 < 4; ++d0) { qA[d0] = *(const bf16x8*)(Qw + d0 * 16 + hi * 8); qB[d0] = *(const bf16x8*)(Qw + 64 + d0 * 16 + hi * 8); }
#pragma unroll
    for (int d0 = 0; d0 < 4; ++d0) asm volatile("" : "+v"(qA[d0]), "+v"(qB[d0]));
    f32x16 oA0, oA1, oB0, oB1;
#pragma unroll
    for (int r = 0; r < 16; ++r) { oA0[r] = 0.f; oA1[r] = 0.f; oB0[r] = 0.f; oB1[r] = 0.f; }
    float lA = 0.f, lB = 0.f;
    const int ntile = u.nctx + u.nloc;
    const int srow = tid >> 3, sch = tid & 7;
    const int qlo = u.qpos0 + wid * 32, qpos = qlo + r32;
    u32x4 kra, vra, krb, vrb;
#define ATT_TID(i, T_) const int j_##T_ = (i); const int T_ = j_##T_ < u.nctx ? 128 + j_##T_ : u.nloc0 + (j_##T_ - u.nctx)
#define ATT_LOAD(i, KR, VR) do { ATT_TID(i, Tl); KR = *(const u32x4*)(u.Klat + (size_t)Tl * 4096 + srow * 64 + sch * 8); VR = *(const u32x4*)(u.Vt + (size_t)Tl * 4096 + srow * 64 + sch * 8); } while (0)
#define ATT_STORE(buf, KR, VR) do { LAS unsigned char* kb_ = lds + (buf) * ABUF; *(LAS u32x4*)(kb_ + srow * KSTR + sch * 16) = KR; \
        LAS u32x2* vd_ = (LAS u32x2*)(kb_ + 64 * KSTR + srow * VSTR + sch * 16); vd_[0] = (u32x2){VR.x, VR.y}; vd_[1] = (u32x2){VR.z, VR.w}; } while (0)
    ATT_LOAD(0, kra, vra); ATT_STORE(0, kra, vra);
    ATT_LOAD(1, kra, vra);
    __syncthreads();
    for (int i = 0; i < ntile; i += 2) {
        if (i + 2 < ntile) ATT_LOAD(i + 2, krb, vrb);
        { ATT_TID(i, T0); attn2_tile(u, lds, T0, qlo, qpos, r32, hi, qA, qB, oA0, oA1, oB0, oB1, lA, lB); }
        ATT_STORE(1, kra, vra);
        __syncthreads();
        if (i + 3 < ntile) ATT_LOAD(i + 3, kra, vra);
        { ATT_TID(i + 1, T1); attn2_tile(u, lds + ABUF, T1, qlo, qpos, r32, hi, qA, qB, oA0, oA1, oB0, oB1, lA, lB); }
        if (i + 2 < ntile) ATT_STORE(0, krb, vrb);
        __syncthreads();
    }
#undef ATT_LOAD
#undef ATT_STORE
#undef ATT_TID
    float ltA = lA + __shfl_xor(lA, 32), ltB = lB + __shfl_xor(lB, 32);
    if (u.has_sink) { ltA += __builtin_amdgcn_exp2f(u.sinkA); ltB += __builtin_amdgcn_exp2f(u.sinkB); }
    const float invA = 1.0f / ltA, invB = 1.0f / ltB;
    bf16_t* Ow = u.O + (size_t)(wid * 32 + r32) * DM;
#pragma unroll
    for (int g = 0; g < 4; ++g) {
        u32x2 w0, w1, w2, w3;
        w0.x = cvtpk(oA0[4 * g] * invA, oA0[4 * g + 1] * invA); w0.y = cvtpk(oA0[4 * g + 2] * invA, oA0[4 * g + 3] * invA);
        w1.x = cvtpk(oA1[4 * g] * invA, oA1[4 * g + 1] * invA); w1.y = cvtpk(oA1[4 * g + 2] * invA, oA1[4 * g + 3] * invA);
        w2.x = cvtpk(oB0[4 * g] * invB, oB0[4 * g + 1] * invB); w2.y = cvtpk(oB0[4 * g + 2] * invB, oB0[4 * g + 3] * invB);
        w3.x = cvtpk(oB1[4 * g] * invB, oB1[4 * g + 1] * invB); w3.y = cvtpk(oB1[4 * g + 2] * invB, oB1[4 * g + 3] * invB);
        *(u32x2*)(Ow + 8 * g + 4 * hi) = w0; *(u32x2*)(Ow + 32 + 8 * g + 4 * hi) = w1;
        *(u32x2*)(Ow + 64 + 8 * g + 4 * hi) = w2; *(u32x2*)(Ow + 96 + 8 * g + 4 * hi) = w3;
    }
}

__device__ __forceinline__ void attn2_phase(bf16_t* PROJ, bf16_t* VT, bf16_t* KT, bf16_t* MIX, const float* sink, bool need_ctx, LAS unsigned char* lds) {
    const int G = gridDim.x; const int bx = opaque_bid(); const int vcu = (G % 8 == 0) ? (bx % 8) * (G / 8) + bx / 8 : bx;
    const int NG = 1024, NW = 512, NCG = need_ctx ? 32 : 0, NCW = need_ctx ? 16 : 0, total = NG + NW + NCG + NCW;
    for (int it = vcu; it < total; it += G) {
        Attn2Desc u; int e = it; u.rot = 0;
        if (e < NG) { const int qt = e & 31, hp = (e >> 5) & 3, b = e >> 7, kvh = hp >> 1, h = 2 * hp; const size_t qrow = (size_t)b * SEQL + 256 * qt;
            u.Q = PROJ + qrow * NPROJ + C_GQ + 64 * h; u.O = MIX + qrow * DM + 256 + 64 * h;
            u.Klat = KT + (size_t)((b * 2 + 0) * 2 + kvh) * 132 * 4096; u.Kctx = u.Klat;
            u.Vt = VT + (size_t)((b * 2 + 0) * 2 + kvh) * 132 * 4096; u.nctx = 4; u.nloc0 = 0; u.nloc = 128; u.win = 0; u.qpos0 = 0; u.has_sink = 0; u.sinkA = 0.f; u.sinkB = 0.f; u.rot = 0;
        } else if ((e -= NG) < NW) { const int qt = e & 31, kvh = (e >> 5) & 1, b = e >> 6, h = 2 * kvh; const size_t qrow = (size_t)b * SEQL + 256 * qt;
            u.Q = PROJ + qrow * NPROJ + C_WQ + 64 * h; u.O = MIX + qrow * DM + 768 + 64 * h;
            u.Klat = KT + (size_t)((b * 2 + 1) * 2 + kvh) * 132 * 4096; u.Kctx = u.Klat;
            u.Vt = VT + (size_t)((b * 2 + 1) * 2 + kvh) * 132 * 4096; u.nctx = 4; const int t0 = 4 * qt - 2 < 0 ? 0 : 4 * qt - 2, t1 = 4 * qt + 6 > 128 ? 128 : 4 * qt + 6;
            u.nloc0 = t0; u.nloc = t1 - t0; u.win = 1; u.qpos0 = 256 * qt; u.has_sink = 1; u.sinkA = sink[h] * LOG2E; u.sinkB = sink[h + 1] * LOG2E;
        } else if ((e -= NW) < NCG) { const int hp = e & 3, b = e >> 2, kvh = hp >> 1, h = 2 * hp; const size_t qrow = (size_t)NLAT + b * NCTX;
            u.Q = PROJ + qrow * NPROJ + C_GQ + 64 * h; u.O = MIX + qrow * DM + 256 + 64 * h;
            u.Klat = KT + (size_t)((b * 2 + 0) * 2 + kvh) * 132 * 4096; u.Kctx = u.Klat;
            u.Vt = VT + (size_t)((b * 2 + 0) * 2 + kvh) * 132 * 4096; u.nctx = 4; u.nloc0 = 0; u.nloc = 0; u.win = 0; u.qpos0 = 0; u.has_sink = 0; u.sinkA = 0.f; u.sinkB = 0.f;
        } else { e -= NCG; const int kvh = e & 1, b = e >> 1, h = 2 * kvh; const size_t qrow = (size_t)NLAT + b * NCTX;
            u.Q = PROJ + qrow * NPROJ + C_WQ + 64 * h; u.O = MIX + qrow * DM + 768 + 64 * h;
            u.Klat = KT + (size_t)((b * 2 + 1) * 2 + kvh) * 132 * 4096; u.Kctx = u.Klat;
            u.Vt = VT + (size_t)((b * 2 + 1) * 2 + kvh) * 132 * 4096; u.nctx = 4; u.nloc0 = 0; u.nloc = 0; u.win = 0; u.qpos0 = 0; u.has_sink = 1; u.sinkA = sink[h] * LOG2E; u.sinkB = sink[h + 1] * LOG2E;
        }
        attn2_unit(u, lds);
    }
}
__device__ __forceinline__ float attn_score_bound(const float* gqg, const float* gkg, const float* wqg, const float* wkg, const float* sink) {
    const int lane = opaque_tid() & 63;
    float a = fabsf(gqg[lane]), b = fabsf(gkg[lane]), c = fabsf(wqg[lane]), d = fabsf(wkg[lane]);
#pragma unroll
    for (int o = 1; o < 64; o <<= 1) { a = fmaxf(a, __shfl_xor(a, o)); b = fmaxf(b, __shfl_xor(b, o)); c = fmaxf(c, __shfl_xor(c, o)); d = fmaxf(d, __shfl_xor(d, o)); }
    float s = fmaxf(fmaxf(fabsf(sink[0]), fabsf(sink[1])), fmaxf(fabsf(sink[2]), fabsf(sink[3]))) * LOG2E;
    const float bd = fmaxf(fmaxf(a * b, c * d) * (64.0f * QSCALE), s);
    return (bd == bd) ? bd : 1e30f;
}

__device__ __forceinline__ void attn_phase(bf16_t* PROJ, bf16_t* VT, bf16_t* KT, bf16_t* MIX, const float* sink, bool need_ctx, LAS unsigned char* lds) {
    const int G = gridDim.x; const int bx = opaque_bid(); const int vcu = (G % 8 == 0) ? (bx % 8) * (G / 8) + bx / 8 : bx;
    const int NG = 2048, NW = 1024, NCG = need_ctx ? 64 : 0, NCW = need_ctx ? 32 : 0, total = NG + NW + NCG + NCW;
    for (int it = vcu; it < total; it += G) {
        AttnDesc u; int e = it;
        if (e < NG) { const int qt = e & 31, h = (e >> 5) & 7, b = e >> 8, kvh = h >> 2; const size_t qrow = (size_t)b * SEQL + 256 * qt;
            u.Q = PROJ + qrow * NPROJ + C_GQ + 64 * h; u.O = MIX + qrow * DM + 256 + 64 * h;
            u.Klat = KT + (size_t)((b * 2 + 0) * 2 + kvh) * 132 * 4096; u.Kctx = u.Klat;
            u.Vt = VT + (size_t)((b * 2 + 0) * 2 + kvh) * 132 * 4096; u.nctx = 4; u.nloc0 = 0; u.nloc = 128; u.win = 0; u.qpos0 = 0; u.has_sink = 0; u.sinkl2 = 0.f;
        } else if ((e -= NG) < NW) { const int qt = e & 31, h = (e >> 5) & 3, b = e >> 7, kvh = h >> 1; const size_t qrow = (size_t)b * SEQL + 256 * qt;
            u.Q = PROJ + qrow * NPROJ + C_WQ + 64 * h; u.O = MIX + qrow * DM + 768 + 64 * h;
            u.Klat = KT + (size_t)((b * 2 + 1) * 2 + kvh) * 132 * 4096; u.Kctx = u.Klat;
            u.Vt = VT + (size_t)((b * 2 + 1) * 2 + kvh) * 132 * 4096; u.nctx = 4; const int t0 = 4 * qt - 2 < 0 ? 0 : 4 * qt - 2, t1 = 4 * qt + 6 > 128 ? 128 : 4 * qt + 6;
            u.nloc0 = t0; u.nloc = t1 - t0; u.win = 1; u.qpos0 = 256 * qt; u.has_sink = 1; u.sinkl2 = sink[h] * LOG2E;
        } else if ((e -= NW) < NCG) { const int h = e & 7, b = e >> 3, kvh = h >> 2; const size_t qrow = (size_t)NLAT + b * NCTX;
            u.Q = PROJ + qrow * NPROJ + C_GQ + 64 * h; u.O = MIX + qrow * DM + 256 + 64 * h;
            u.Klat = KT + (size_t)((b * 2 + 0) * 2 + kvh) * 132 * 4096; u.Kctx = u.Klat;
            u.Vt = VT + (size_t)((b * 2 + 0) * 2 + kvh) * 132 * 4096; u.nctx = 4; u.nloc0 = 0; u.nloc = 0; u.win = 0; u.qpos0 = 0; u.has_sink = 0; u.sinkl2 = 0.f;
        } else { e -= NCG; const int h = e & 3, b = e >> 2, kvh = h >> 1; const size_t qrow = (size_t)NLAT + b * NCTX;
            u.Q = PROJ + qrow * NPROJ + C_WQ + 64 * h; u.O = MIX + qrow * DM + 768 + 64 * h;
            u.Klat = KT + (size_t)((b * 2 + 1) * 2 + kvh) * 132 * 4096; u.Kctx = u.Klat;
            u.Vt = VT + (size_t)((b * 2 + 1) * 2 + kvh) * 132 * 4096; u.nctx = 4; u.nloc0 = 0; u.nloc = 0; u.win = 0; u.qpos0 = 0; u.has_sink = 1; u.sinkl2 = sink[h] * LOG2E;
        }
        attn_unit(u, lds);
    }
}

#define XB_TMO      128
#define XB_XCNT(j)  (256  + 64 * (j))
#define XB_XSUB(j)  (1280 + 64 * (j))
#define XB_XGEN(j)  (2304 + 64 * (j))
#define XB_TOP      3328
#define XB_TOPGEN   3392
#define XCD_BAR_WORDS 3456
#define XB_SPIN_CAP (1u << 18)

__device__ __forceinline__ unsigned xb_ld(unsigned* p)              { return __hip_atomic_load(p, __ATOMIC_RELAXED, __HIP_MEMORY_SCOPE_AGENT); }
__device__ __forceinline__ unsigned xb_add(unsigned* p, unsigned v) { return __hip_atomic_fetch_add(p, v, __ATOMIC_RELAXED, __HIP_MEMORY_SCOPE_AGENT); }
__device__ __forceinline__ unsigned xb_xcc_id() { return (unsigned)__builtin_amdgcn_s_getreg((3 << 11) | 20) & 0xFu; }
#define XB_SPIN(cond, bar) do { unsigned _sp = 0; while (cond) { __builtin_amdgcn_s_sleep(1); \
    if ((++_sp & 255u) == 0u) { if (xb_ld(&(bar)[XB_TMO])) break; if (_sp > XB_SPIN_CAP) { atomicAdd(&(bar)[XB_TMO], 1u); break; } } } } while (0)

struct XcdBarrier {
    unsigned* bar; unsigned x;
    volatile LAS unsigned* st;
};

__device__ __forceinline__ XcdBarrier xcd_barrier_post(unsigned* bar, volatile LAS unsigned* st) {
    XcdBarrier b; b.bar = bar; b.x = xb_xcc_id(); b.st = st;
    if (threadIdx.x == 0) (void)xb_add(&bar[XB_XCNT(b.x)], 1u);
    return b;
}
__device__ __forceinline__ void xcd_barrier_complete(unsigned* bar, unsigned x, unsigned& nloc, unsigned& nx) {
    const unsigned G = gridDim.x * gridDim.y * gridDim.z;
    unsigned sum, cnt, mine, sp = 0u;
    for (;;) {
        sum = 0u; cnt = 0u; mine = 0u;
#pragma unroll
        for (unsigned j = 0; j < 16; ++j) { const unsigned c = xb_ld(&bar[XB_XCNT(j)]); sum += c; cnt += (c > 0u) ? 1u : 0u; mine = (j == x) ? c : mine; }
        if (sum == G) break;
        __builtin_amdgcn_s_sleep(1);
        if ((++sp & 255u) == 0u) { if (xb_ld(&bar[XB_TMO])) break; if (sp > XB_SPIN_CAP) { atomicAdd(&bar[XB_TMO], 1u); break; } }
    }
    nloc = mine > 0u ? mine : 1u; nx = cnt > 0u ? cnt : 1u;
}

__device__ __forceinline__ void xcd_barrier(const XcdBarrier& b) {
    asm volatile("s_waitcnt vmcnt(0)" ::: "memory");
    __syncthreads();
    if (threadIdx.x == 0) {
        unsigned* bar = b.bar;
        __builtin_amdgcn_s_waitcnt(0);
        unsigned nloc = b.st[0], nx = b.st[1];
        if (nloc == 0u) { xcd_barrier_complete(bar, b.x, nloc, nx); b.st[0] = nloc; b.st[1] = nx; }
        const unsigned old = xb_add(&bar[XB_XSUB(b.x)], 1u);
        const unsigned gen = old / nloc;
        if (old + 1u == (gen + 1u) * nloc) {
            __builtin_amdgcn_fence(__ATOMIC_RELEASE, "agent");
            asm volatile("s_waitcnt vmcnt(0)" ::: "memory");
            const unsigned og = xb_add(&bar[XB_TOP], 1u);
            const unsigned tg = og / nx;
            if (og + 1u == (tg + 1u) * nx) xb_add(&bar[XB_TOPGEN], 1u);
            else XB_SPIN(xb_ld(&bar[XB_TOPGEN]) == tg, bar);
            __builtin_amdgcn_fence(__ATOMIC_ACQUIRE, "agent");
            xb_add(&bar[XB_XGEN(b.x)], 1u);
            asm volatile("s_waitcnt vmcnt(0)" ::: "memory");
        } else {
            XB_SPIN(xb_ld(&bar[XB_XGEN(b.x)]) == gen, bar);
            __builtin_amdgcn_fence(__ATOMIC_ACQUIRE, "agent");
            asm volatile("s_waitcnt vmcnt(0)" ::: "memory");
        }
    }
    __syncthreads();
}

constexpr int LDS_BYTES = 147456;
constexpr int N_PHASES = 20;

__global__ void __launch_bounds__(512, 2) hymba_fwd(Args a) {
    extern __shared__ __attribute__((aligned(16))) unsigned char lds_raw[];
    LAS unsigned char* lds = (LAS unsigned char*)lds_raw;
    cg::grid_group grid = cg::this_grid();
    volatile LAS unsigned* MISC = (volatile LAS unsigned*)(lds + 131072 + 320);
    if (threadIdx.x < 32) MISC[threadIdx.x] = 0u;
    __syncthreads();
    XcdBarrier xbar = xcd_barrier_post((unsigned*)a.ws + 4096, MISC + 8);
    const int G = gridDim.x;
    for (int ph = a.ph_lo; ph < a.ph_hi; ++ph) {
    __attribute__((address_space(1))) unsigned char* wsg = (__attribute__((address_space(1))) unsigned char*)a.ws; asm volatile("" : "+s"(wsg));
    unsigned char* ws = (unsigned char*)wsg;
    const int bid = opaque_bid();
    float* MOD = (float*)(ws + WS_MOD); float* ROPE = (float*)(ws + WS_ROPE);
    bf16_t* XN = (bf16_t*)(ws + WS_XN); bf16_t* HID = (bf16_t*)(ws + WS_HID); bf16_t* PROJ = (bf16_t*)(ws + WS_HID);
    bf16_t* VT = (bf16_t*)(ws + WS_VT); float* Gg = (float*)(ws + WS_G); float* DS = (float*)(ws + WS_DS); float* DEC = (float*)(ws + WS_DEC); bf16_t* MIX = (bf16_t*)a.out; bf16_t* XB = (bf16_t*)(ws + WS_XB); bf16_t* KT = (bf16_t*)(ws + WS_KT);
    float* SSQ = (float*)(ws + WS_SSQ); const float* GM = (const float*)(ws + WS_GM); const float* BIAS = (const float*)(ws + WS_BIAS);
        if (ph == 0) { prologue_phase(a, lds); }
        else if (ph == 1) { bias_phase(a); norm_phase(a.in[0], a.in[2], XN, XB, a.in[6], MOD, SSQ, MT); }
        else {
            const int idx = ph - 2, l = idx / 9, j = idx % 9, s = j + 1 + (j >= 2 ? 1 : 0) + (j >= 7 ? 1 : 0); const bool last = (l == 1);
            const unsigned char* wl = ws + WS_W + (size_t)l * W_LAYER; const float* modl = MOD + (size_t)l * 9 * MODW;
            switch (s) {
            case 1: case 10: {
                const int M = (s == 10 && last) ? NLAT : MT; const int w = s == 1 ? 0 : 2;
                pg8::Gemm g{XN, (const bf16_t*)(wl + (s == 1 ? WO_F1I : WO_F2I)), M, 2 * FH, DM}; pg8::StaticOrder S; S.init(M, 2 * FH, G, bid);
                pg8::EpiSwiglu E{HID, SSQ + (size_t)(l * 3 + w) * MT, BIAS + (size_t)(l * 3 + w) * 9 * BIASN};
                pg8::gemm_phase<pg8::EpiSwiglu, pg8::StaticOrder, true, true>(lds, g, S, E);
            } break;
            case 2: case 11: {
                const int M = (s == 11 && last) ? NLAT : MT;
                const int ni = s == 2 ? l * 3 + 1 : 3;
                const bool has_next = !(s == 11 && last);
                pg8::Gemm g{HID, (const bf16_t*)(wl + (s == 2 ? WO_F1O : WO_F2O)), M, DM, FH}; pg8::StaticOrder S; S.init(M, DM, G, bid);
                pg8::EpiResid E{XB, a.out, modl + (s == 2 ? 2 : 8) * DM, XN, GM + (size_t)ni * 9 * DM, SSQ + (size_t)ni * MT, 0.5f, has_next ? 1 : 0, has_next ? 0 : 1};
                pg8::gemm_phase<pg8::EpiResid, pg8::StaticOrder, true, true>(lds, g, S, E);
            } break;
            case 4: {
                pg8::Gemm g{XN, (const bf16_t*)(wl + WO_MI), MT, NPROJ, DM}; pg8::StaticOrder S; S.init(MT, NPROJ, G, bid);
                pg8::EpiInproj E{PROJ, Gg, a.in[13] + l * 128, a.in[15] + l * 128, SSQ + (size_t)(l * 3 + 1) * MT, BIAS + (size_t)(l * 3 + 1) * 9 * BIASN};
                pg8::gemm_phase<pg8::EpiInproj, pg8::StaticOrder, true, true>(lds, g, S, E);
            } break;
            case 5: {
                for (int un = bid; un < MT / 64; un += G) prep_unit(un, PROJ, VT, KT, ROPE, a.in[17] + l * 64, a.in[18] + l * 64, a.in[19] + l * 64, a.in[20] + l * 64, lds);
                for (int gp = bid; gp < 32 * 33; gp += G) gla_g1_mfma(gp, PROJ, Gg, DS, DEC, lds);
            } break;
            case 6: {
                for (int ch = bid; ch < 256; ch += G) gla_scan_chain(ch, DS, DEC);
                __syncthreads();
                { const float bound = attn_score_bound(a.in[17] + l * 64, a.in[18] + l * 64, a.in[19] + l * 64, a.in[20] + l * 64, a.in[21] + l * 4);
                  if (__builtin_amdgcn_readfirstlane(bound <= 40.0f ? 1 : 0)) attn2_phase(PROJ, VT, KT, MIX, a.in[21] + l * 4, !last, lds);
                  else attn_phase(PROJ, VT, KT, MIX, a.in[21] + l * 4, !last, lds); }
            } break;
            case 7: {
                for (int gp = bid; gp < 32 * 33; gp += G) { if (last && (gp % 33) == 0) continue; gla_g3_mfma(gp, PROJ, Gg, DS, a.in[16] + l * 64, MIX, lds); }
            } break;
            case 8: {
                const int M = last ? NLAT : MT; const int ni = l * 3 + 2;
                pg8::Gemm g{MIX, (const bf16_t*)(wl + WO_MO), M, DM, DM}; pg8::StaticOrder S; S.init(M, DM, G, bid);
                pg8::EpiResid E{XB, a.out, modl + 5 * DM, XN, GM + (size_t)ni * 9 * DM, SSQ + (size_t)ni * MT, 1.0f, 1, 0};
                pg8::gemm_phase<pg8::EpiResid, pg8::StaticOrder, true, true>(lds, g, S, E);
            } break;
            default: break;
            }
        }
        if (ph + 1 < a.ph_hi) { if (a.ph_lo < 0) grid.sync(); else xcd_barrier(xbar); }
    }
}

#ifndef MK_PER_PHASE
#define MK_PER_PHASE 0
#endif
extern "C" void kernel_launch(void* const* d_in, const int* in_sizes, int n_in, void* d_out, int out_size, void* d_ws, size_t ws_size, hipStream_t stream) {
    static int grid = 0;
    if (grid == 0) {
        if (n_in != 25 || ws_size < WS_END) { fprintf(stderr, "kernel_launch: unexpected n_in %d / ws_size %zu (need %zu)\n", n_in, ws_size, (size_t)WS_END); grid = -1; return; }
        int dev = 0, cus = 0, per_cu = 0;
        hipGetDevice(&dev); hipDeviceGetAttribute(&cus, hipDeviceAttributeMultiprocessorCount, dev);
        if (hipFuncSetAttribute((const void*)hymba_fwd, hipFuncAttributeMaxDynamicSharedMemorySize, LDS_BYTES) != hipSuccess) { fprintf(stderr, "kernel_launch: hipFuncSetAttribute failed\n"); grid = -1; return; }
        if (hipOccupancyMaxActiveBlocksPerMultiprocessor(&per_cu, (const void*)hymba_fwd, 512, LDS_BYTES) != hipSuccess || per_cu < 1) { fprintf(stderr, "kernel_launch: occupancy query says %d\n", per_cu); per_cu = 1; }
        (void)hipGetLastError();
        grid = cus * 1;
    }
    if (grid < 0) return;
    if (hipMemsetAsync(d_ws, 0, WS_CTLB + (size_t)6 * MT * 4, stream) != hipSuccess) { fprintf(stderr, "kernel_launch: memset failed\n"); return; }
    Args a{};
    for (int i = 0; i < 25; ++i) a.in[i] = (const float*)d_in[i];
    a.out = (float*)d_out; a.ws = (unsigned char*)d_ws;
#if MK_PER_PHASE
    for (int ph = 0; ph < N_PHASES; ++ph) { a.ph_lo = ph; a.ph_hi = ph + 1; hipLaunchKernelGGL(hymba_fwd, dim3(grid), dim3(512), LDS_BYTES, stream, a); }
#else
    a.ph_lo = 0; a.ph_hi = N_PHASES;
    void* args[] = {&a};
    hipError_t e = hipLaunchCooperativeKernel((const void*)hymba_fwd, dim3(grid), dim3(512), args, LDS_BYTES, stream);
    if (e != hipSuccess) fprintf(stderr, "kernel_launch: cooperative launch failed: %s (grid %d)\n", hipGetErrorString(e), grid);
#endif
}
```

```cpp
#include <hip/hip_runtime.h>
#include <hip/hip_cooperative_groups.h>
#include <cstdio>
#include <cstdint>
namespace cg = cooperative_groups;
__device__ __forceinline__ int opaque_tid() { int t = threadIdx.x; asm volatile("" : "+v"(t)); return t; }
__device__ __forceinline__ int opaque_bid() { int b = blockIdx.x; asm volatile("" : "+s"(b)); return b; }
namespace pg8 {
#define PG8_LAS __attribute__((address_space(3)))
typedef unsigned short bf16_t;
typedef short bf16x8 __attribute__((ext_vector_type(8)));
typedef float f32x4 __attribute__((ext_vector_type(4)));
typedef unsigned u32x4 __attribute__((ext_vector_type(4)));
constexpr int BM = 256, BK = 64, HALF = 128, HTB = HALF * BK * 2  , STAGE_BYTES = 8 * HTB, NXCD = 8, WGM = 8;

__host__ __device__ __forceinline__ int lds_byte(int r, int c) { const int st = (r >> 4) * 2 + (c >> 5), rr = r & 15, cc = c & 31, ob = rr * 64 + cc * 2; return st * 1024 + (ob ^ (((ob >> 9) & 1) << 5)); }
__host__ __device__ __forceinline__ void stage_rc(int b, int& R, int& C) { const int st = b / 1024, sb = b % 1024, swz = sb ^ (((sb >> 9) & 1) << 5); R = (st >> 1) * 16 + swz / 64; C = (st & 1) * 32 + (swz % 64) / 2; }
__host__ __device__ __forceinline__ int perm32(int rho) { const int n = rho >> 4, i = rho & 15; return 8 * (i >> 2) + 4 * n + (i & 3); }

struct Unit { int pm, pn; };
struct Gemm { const bf16_t* A; const bf16_t* Bt; int M, N, K; };

struct StaticOrder {
    int nM, nN, nwg, G, c;
    __host__ __device__ void init(int M, int N, int G_, int c_) { nM = M / BM; nN = N / BM; nwg = nM * nN; G = G_; c = c_; }
    __host__ __device__ bool next(int i, Unit& u) const {
        const long L = (long)i * G + c; if (L >= nwg) return false;
        int wgid = (int)L; { const int q = nwg / NXCD, r = nwg % NXCD, xcd = wgid % NXCD, off = wgid / NXCD; wgid = (xcd < r ? xcd * (q + 1) : r * (q + 1) + (xcd - r) * q) + off; }
        const int nig = WGM * nN, gid = wgid / nig, fm = gid * WGM, gsz = (nM - fm) < WGM ? (nM - fm) : WGM;
        u.pm = fm + ((wgid % nig) % gsz); u.pn = (wgid % nig) / gsz; return true;
    }
    __device__ __forceinline__ void a_ready(const Unit&) const {}
    __device__ __forceinline__ void done(const Unit&) const {}
};

__device__ __forceinline__ unsigned cvt_pk_bf16(float lo, float hi) { unsigned r; asm volatile("v_cvt_pk_bf16_f32 %0, %1, %2" : "=v"(r) : "v"(lo), "v"(hi)); return r; }
typedef float f32x2 __attribute__((ext_vector_type(2)));
template <class Epi, class Sched, bool ALIGN_EPI = false, bool SP2 = false>
__device__ __forceinline__ void gemm_phase(PG8_LAS unsigned char* lds, const Gemm g, const Sched& S, const Epi& E) {
    const int tid = opaque_tid(), wid = __builtin_amdgcn_readfirstlane(tid >> 6), lane = tid & 63, wr = wid >> 2, wc = wid & 3, fr = lane & 15, fq = lane >> 4;
    const int K = g.K, nt = K / BK;
    unsigned voffA[2], voffB[2];
#pragma unroll
    for (int i = 0; i < 2; ++i) { int R, C; stage_rc(tid * 16 + i * 8192, R, C); const int Rb = Epi::PERM ? ((R & ~31) + perm32(R & 31)) : R;
        voffA[i] = (unsigned)(R * K + C) * 2u; voffB[i] = (unsigned)(Rb * K + C) * 2u; }
    const size_t kstep = (size_t)(BK * 2);
    const size_t hstep = (size_t)HALF * K * 2;
    const size_t tstep = 2 * hstep;
    const unsigned ldsw = (unsigned)wid * 1024u;
    const int aoff = lds_byte(wr * 64 + fr, fq * 8), boff = lds_byte(wc * 32 + fr, fq * 8);
#define PG8_SA(b, h) (((b) * 2 + (h)) * HTB)
#define PG8_SB(b, h) ((4 + (b) * 2 + (h)) * HTB)
#define PG8_STAGE(bufoff, gbase, voff) do { _Pragma("unroll") for (int _i = 0; _i < 2; ++_i) \
        __builtin_amdgcn_global_load_lds((const unsigned*)((const char*)(gbase) + (voff)[_i]), (PG8_LAS unsigned*)(lds + (bufoff) + ldsw + _i * 8192), 16, 0, 0); } while (0)
#define PG8_LDA(dst, b, h) do { _Pragma("unroll") for (int m = 0; m < 4; ++m) _Pragma("unroll") for (int k = 0; k < 2; ++k) dst[m][k] = *(const PG8_LAS bf16x8*)(lds + PG8_SA(b, h) + aoff + m * 2048 + k * 1024); } while (0)
#define PG8_LDB(dst, b, h) do { _Pragma("unroll") for (int n = 0; n < 2; ++n) _Pragma("unroll") for (int k = 0; k < 2; ++k) dst[n][k] = *(const PG8_LAS bf16x8*)(lds + PG8_SB(b, h) + boff + n * 2048 + k * 1024); } while (0)
#define PG8_MMA(ai, bj, At, Bt) do { __builtin_amdgcn_s_setprio(1); _Pragma("unroll") for (int m = 0; m < 4; ++m) _Pragma("unroll") for (int n = 0; n < 2; ++n) _Pragma("unroll") for (int k = 0; k < 2; ++k) \
        acc[ai][bj][m][n] = __builtin_amdgcn_mfma_f32_16x16x32_bf16(Bt[n][k], At[m][k], acc[ai][bj][m][n], 0, 0, 0); __builtin_amdgcn_s_setprio(0); } while (0)
#define PG8_WAIT_V(n) asm volatile("s_waitcnt vmcnt(" #n ")" ::: "memory")
#define PG8_WAIT_L(n) asm volatile("s_waitcnt lgkmcnt(" #n ")" ::: "memory")
#define PG8_BAR __builtin_amdgcn_s_barrier()
#define PG8_SCHED __builtin_amdgcn_sched_barrier(0)
    Unit cur, nxt; int ui = 0; typename Epi::Pre pre;
    if (!S.next(0, cur)) return;
    f32x4 acc[2][2][4][2];
#pragma unroll
    for (int a = 0; a < 2; ++a)
#pragma unroll
        for (int b = 0; b < 2; ++b)
#pragma unroll
            for (int m = 0; m < 4; ++m)
#pragma unroll
                for (int n = 0; n < 2; ++n) acc[a][b][m][n] = (f32x4){0.f, 0.f, 0.f, 0.f};
    bf16x8 At[4][2], B0[2][2], B1[2][2];
    const char* cA = (const char*)g.A + (size_t)cur.pm * tstep; const char* cB = (const char*)g.Bt + (size_t)cur.pn * tstep;
    S.a_ready(cur);
    if constexpr (SP2) {
        PG8_STAGE(PG8_SB(0, 0), cB, voffB); PG8_STAGE(PG8_SB(0, 1), cB + hstep, voffB); PG8_STAGE(PG8_SA(0, 0), cA, voffA); PG8_STAGE(PG8_SA(0, 1), cA + hstep, voffA);
        if (wr == 1) PG8_BAR;
        PG8_WAIT_V(2); PG8_BAR;
        PG8_STAGE(PG8_SB(1, 0), cB + kstep, voffB); PG8_STAGE(PG8_SA(1, 0), cA + kstep, voffA); PG8_STAGE(PG8_SB(1, 1), cB + hstep + kstep, voffB);
        PG8_WAIT_V(6); PG8_BAR;
    } else {
        PG8_STAGE(PG8_SB(0, 0), cB, voffB); PG8_STAGE(PG8_SA(0, 0), cA, voffA); PG8_STAGE(PG8_SB(0, 1), cB + hstep, voffB); PG8_STAGE(PG8_SA(0, 1), cA + hstep, voffA);
        if (wr == 1) PG8_BAR;
        PG8_WAIT_V(4); PG8_BAR;
        PG8_STAGE(PG8_SB(1, 0), cB + kstep, voffB); PG8_STAGE(PG8_SA(1, 0), cA + kstep, voffA); PG8_STAGE(PG8_SB(1, 1), cB + hstep + kstep, voffB);
        PG8_WAIT_V(6); PG8_BAR;
    }
    for (;;) {
        const bool has_next = S.next(ui + 1, nxt);
        const char* nA = has_next ? (const char*)g.A + (size_t)nxt.pm * tstep : cA; const char* nB = has_next ? (const char*)g.Bt + (size_t)nxt.pn * tstep : cB;
        for (int t = 0; t < nt; t += 2) {
            const bool last = (t == nt - 2);
            const char* a1 = cA + (size_t)(t + 1) * kstep;
            const char* a2 = last ? nA : cA + (size_t)(t + 2) * kstep; const char* b2 = last ? nB : cB + (size_t)(t + 2) * kstep;
            const char* a3 = a2 + kstep; const char* b3 = b2 + kstep;
            if (last && has_next) S.a_ready(nxt);
            if (last) E.prefetch(cur, wr, fr, pre);
            if constexpr (SP2) {
            PG8_LDB(B0, 0, 0); PG8_LDB(B1, 0, 1); PG8_SCHED; PG8_LDA(At, 0, 0); PG8_STAGE(PG8_SA(1, 1), a1 + hstep, voffA);
            PG8_WAIT_V(8); PG8_WAIT_L(0); PG8_BAR; PG8_MMA(0, 0, At, B0); PG8_MMA(0, 1, At, B1); PG8_BAR; PG8_SCHED;
            PG8_LDA(At, 0, 1); PG8_STAGE(PG8_SB(0, 0), b2, voffB); PG8_STAGE(PG8_SB(0, 1), b2 + hstep, voffB); PG8_STAGE(PG8_SA(0, 0), a2, voffA);
            PG8_WAIT_V(8); PG8_WAIT_L(0); PG8_BAR; PG8_MMA(1, 0, At, B0); PG8_MMA(1, 1, At, B1); PG8_BAR; PG8_SCHED;
            PG8_LDB(B0, 1, 0); PG8_LDB(B1, 1, 1); PG8_SCHED; PG8_LDA(At, 1, 0); PG8_STAGE(PG8_SA(0, 1), a2 + hstep, voffA);
            PG8_WAIT_V(8); PG8_WAIT_L(0); PG8_BAR; PG8_MMA(0, 0, At, B0); PG8_MMA(0, 1, At, B1); PG8_BAR; PG8_SCHED;
            PG8_LDA(At, 1, 1); PG8_STAGE(PG8_SB(1, 0), b3, voffB); PG8_STAGE(PG8_SB(1, 1), b3 + hstep, voffB); PG8_STAGE(PG8_SA(1, 0), a3, voffA);
            PG8_WAIT_V(8); PG8_WAIT_L(0); PG8_BAR; PG8_MMA(1, 0, At, B0); PG8_MMA(1, 1, At, B1); PG8_BAR; PG8_SCHED;
            } else {
            PG8_LDB(B0, 0, 0); PG8_SCHED; PG8_LDA(At, 0, 0); PG8_STAGE(PG8_SA(1, 1), a1 + hstep, voffA);
            PG8_WAIT_L(8); PG8_BAR; PG8_WAIT_L(0); PG8_MMA(0, 0, At, B0); PG8_BAR; PG8_SCHED;
            PG8_LDB(B1, 0, 1); PG8_STAGE(PG8_SB(0, 0), b2, voffB);
            PG8_BAR; PG8_WAIT_L(0); PG8_MMA(0, 1, At, B1); PG8_BAR;
            PG8_LDA(At, 0, 1); PG8_STAGE(PG8_SA(0, 0), a2, voffA);
            PG8_BAR; PG8_WAIT_L(0); PG8_MMA(1, 0, At, B0); PG8_BAR; PG8_SCHED;
            PG8_STAGE(PG8_SB(0, 1), b2 + hstep, voffB);
            PG8_WAIT_V(6); PG8_BAR; PG8_MMA(1, 1, At, B1); PG8_BAR;
            PG8_LDB(B0, 1, 0); PG8_SCHED; PG8_LDA(At, 1, 0); PG8_STAGE(PG8_SA(0, 1), a2 + hstep, voffA);
            PG8_WAIT_L(8); PG8_BAR; PG8_WAIT_L(0); PG8_MMA(0, 0, At, B0); PG8_BAR; PG8_SCHED;
            PG8_LDB(B1, 1, 1); PG8_STAGE(PG8_SB(1, 0), b3, voffB);
            PG8_BAR; PG8_WAIT_L(0); PG8_MMA(0, 1, At, B1); PG8_BAR;
            PG8_LDA(At, 1, 1); PG8_STAGE(PG8_SA(1, 0), a3, voffA);
            PG8_BAR; PG8_WAIT_L(0); PG8_MMA(1, 0, At, B0); PG8_BAR; PG8_SCHED;
            PG8_STAGE(PG8_SB(1, 1), b3 + hstep, voffB);
            PG8_WAIT_V(6); PG8_BAR; PG8_MMA(1, 1, At, B1); PG8_BAR;
            }
        }
        if constexpr (ALIGN_EPI) { if (wr == 0) PG8_BAR; }
        if constexpr (!Epi::AFTER_DRAIN) { E(acc, cur, wr, wc, fr, fq, pre); S.done(cur); }
        if (!has_next) break;
#pragma unroll
        for (int a = 0; a < 2; ++a)
#pragma unroll
            for (int b = 0; b < 2; ++b)
#pragma unroll
                for (int m = 0; m < 4; ++m)
#pragma unroll
                    for (int n = 0; n < 2; ++n) acc[a][b][m][n] = (f32x4){0.f, 0.f, 0.f, 0.f};
        cur = nxt; cA = nA; cB = nB; ++ui;
        if constexpr (ALIGN_EPI) { if (wr == 1) PG8_BAR; }
    }
    PG8_WAIT_V(0);
    if constexpr (!ALIGN_EPI) { if (wr == 0) PG8_BAR; }
    PG8_BAR;
    if constexpr (Epi::AFTER_DRAIN) { E.fused(acc, cur, wr, wc, fr, fq, lds, wid, lane); S.done(cur); }
#undef PG8_SA
#undef PG8_SB
#undef PG8_STAGE
#undef PG8_LDA
#undef PG8_LDB
#undef PG8_MMA
#undef PG8_WAIT_V
#undef PG8_WAIT_L
#undef PG8_BAR
#undef PG8_SCHED
}
}

constexpr int DM = 1024, NB = 8, SEQL = 8192, NCTX = 256, NLAT = NB * SEQL, MT = NLAT + NB * NCTX;
constexpr int FH = 2816, NPROJ = 2304, NMOD = 9, MODW = NMOD * DM, NKEY = SEQL + NCTX;
constexpr int NCHUNK = 132;
constexpr float EPS = 1e-6f;
constexpr int C_AQ = 0, C_AK = 128, C_AV = 256, C_AR = 512, C_GQ = 1024, C_GK = 1536, C_GV = 1664, C_WQ = 1792, C_WK = 2048, C_WV = 2176;
constexpr float QSCALE = 0.125f * 1.4426950408889634f;
constexpr float LOG2E = 1.4426950408889634f;

constexpr size_t MiB = 1u << 20;
constexpr size_t WS_CTLB = 65536, WS_SSQ = WS_CTLB, WS_MOD = 2 * MiB, WS_ROPE = 3 * MiB, WS_W = 6 * MiB;
constexpr size_t W_FFN_IN = (size_t)2 * FH * DM * 2, W_FFN_OUT = (size_t)DM * FH * 2, W_MIX_IN = (size_t)NPROJ * DM * 2, W_MIX_OUT = (size_t)DM * DM * 2;
constexpr size_t WO_F1I = 0, WO_F1O = WO_F1I + W_FFN_IN, WO_F2I = WO_F1O + W_FFN_OUT, WO_F2O = WO_F2I + W_FFN_IN, WO_MI = WO_F2O + W_FFN_OUT, WO_MO = WO_MI + W_MIX_IN, W_LAYER = WO_MO + W_MIX_OUT;
constexpr size_t WS_XC = WS_W + 2 * W_LAYER;
constexpr size_t WS_XN = WS_XC + (size_t)NB * NCTX * DM * 4;
constexpr size_t WS_HID = WS_XN + (size_t)MT * DM * 2;
constexpr size_t WS_VT = WS_HID + (size_t)MT * FH * 2;
constexpr size_t WS_G = WS_VT + (size_t)NB * 2 * 2 * 64 * NKEY * 2;
constexpr size_t WS_DS = WS_G + (size_t)MT * 256 * 4;
constexpr size_t WS_DEC = WS_DS + (size_t)32 * 2 * NCHUNK * 2048 * 4;
constexpr size_t WS_XB = WS_DEC + 2 * MiB;
constexpr size_t WS_SSQ_UNUSED = WS_XB + (size_t)MT * DM * 2;
static_assert(WS_SSQ + (size_t)6 * MT * 4 <= WS_MOD, "ctl map");
constexpr size_t WS_GM = WS_SSQ_UNUSED;
constexpr size_t WS_BIAS = WS_GM + 1 * MiB;
constexpr int BIASN = 2 * FH;
constexpr size_t WS_KT = WS_BIAS + 2 * MiB;
constexpr size_t WS_END = WS_KT + (size_t)NB * 4 * 132 * 4096 * 2;
static_assert(WS_END <= (size_t)1024 * MiB, "d_ws map");

typedef unsigned short bf16_t;
typedef short bf16x8 __attribute__((ext_vector_type(8)));
typedef short s16x4 __attribute__((ext_vector_type(4)));
typedef float f32x4 __attribute__((ext_vector_type(4)));
typedef float f32x16 __attribute__((ext_vector_type(16)));
typedef unsigned u32x4 __attribute__((ext_vector_type(4)));
typedef unsigned u32x2 __attribute__((ext_vector_type(2)));
#define LAS __attribute__((address_space(3)))

__device__ __forceinline__ unsigned f2bf(float f) { unsigned u = __builtin_bit_cast(unsigned, f); return (u + 0x7fffu + ((u >> 16) & 1u)) >> 16; }
__device__ __forceinline__ unsigned pk2(float lo, float hi) { return f2bf(lo) | (f2bf(hi) << 16); }
__device__ __forceinline__ float bf2f(unsigned short b) { return __builtin_bit_cast(float, (unsigned)b << 16); }
__device__ __forceinline__ float silu_f(float a) { return a * __builtin_amdgcn_rcpf(1.0f + __expf(-a)); }
__device__ __forceinline__ float wave_sum(float v) {
#pragma unroll
    for (int o = 1; o < 64; o <<= 1) v += __shfl_xor(v, o);
    return v;
}

struct Args {
    const float* in[25]; float* out; unsigned char* ws; int ph_lo, ph_hi;
};

namespace pg8 {
struct EpiSwiglu {
    static constexpr bool PERM = true, AFTER_DRAIN = false;
    struct Pre { float q[8]; };
    __device__ __forceinline__ void prefetch(const Unit& u, int wr, int fr, Pre& p) const {
        const int row0 = u.pm * BM + wr * 64 + fr;
#pragma unroll
        for (int j = 0; j < 8; ++j) p.q[j] = ssqp[row0 + (j >> 2) * HALF + (j & 3) * 16];
    }
    bf16_t* O; const float* ssqp; const float* bias;
    __device__ __forceinline__ void operator()(const f32x4 (&acc)[2][2][4][2], const Unit& u, int wr, int wc, int fr, int fq, const Pre& pre) const {
        const int row0 = u.pm * BM + wr * 64 + fr, col0 = u.pn * 128 + wc * 32 + 8 * fq;
        const int s = u.pm < (NLAT / BM) ? (u.pm >> 5) : 8;
        const float* bp = bias + (size_t)s * BIASN + u.pn * BM + wc * 32 + 8 * fq;
        const f32x4 ba0 = *(const f32x4*)bp, ba1 = *(const f32x4*)(bp + 4), bb0 = *(const f32x4*)(bp + HALF), bb1 = *(const f32x4*)(bp + HALF + 4);
#pragma unroll
        for (int ai = 0; ai < 2; ++ai)
#pragma unroll
            for (int m = 0; m < 4; ++m) {
                const int row = row0 + ai * HALF + m * 16;
                const float rstd = rsqrtf(pre.q[ai * 4 + m] * (1.0f / DM) + EPS);
                bf16_t* rowp = O + (size_t)row * FH + col0;
                const f32x4 a0 = acc[ai][0][m][0] * rstd + ba0, a1 = acc[ai][0][m][1] * rstd + ba1, b0 = acc[ai][1][m][0] * rstd + bb0, b1 = acc[ai][1][m][1] * rstd + bb1;
                u32x4 w;
                w.x = cvt_pk_bf16(silu_f(a0[0]) * b0[0], silu_f(a0[1]) * b0[1]); w.y = cvt_pk_bf16(silu_f(a0[2]) * b0[2], silu_f(a0[3]) * b0[3]);
                w.z = cvt_pk_bf16(silu_f(a1[0]) * b1[0], silu_f(a1[1]) * b1[1]); w.w = cvt_pk_bf16(silu_f(a1[2]) * b1[2], silu_f(a1[3]) * b1[3]);
                *(u32x4*)rowp = w;
            }
    }
};
struct EpiResid {
    static constexpr bool PERM = true, AFTER_DRAIN = false;
    struct Pre {}; __device__ __forceinline__ void prefetch(const Unit&, int, int, Pre&) const {}
    bf16_t* xb; float* fout; const float* gate;
    bf16_t* xnp; const float* gm; float* ssqp; float coef; int xn, fin;
    __device__ __forceinline__ void operator()(const f32x4 (&acc)[2][2][4][2], const Unit& u, int wr, int wc, int fr, int fq, const Pre&) const {
        const int s = u.pm < (NLAT / BM) ? (u.pm >> 5) : 8;
        const size_t rowbase = (size_t)u.pm * BM;
        const int col0 = u.pn * BM + wc * 32 + 8 * fq;
        f32x4 g[2][2], gmv[2][2];
#pragma unroll
        for (int bj = 0; bj < 2; ++bj)
#pragma unroll
            for (int n = 0; n < 2; ++n) { g[bj][n] = *(const f32x4*)(gate + (size_t)s * MODW + col0 + bj * HALF + n * 4) * coef;
                gmv[bj][n] = *(const f32x4*)(gm + (size_t)s * DM + col0 + bj * HALF + n * 4); }
        u32x4 cur[2], nxt[2]; int rcur, rnxt;
        rcur = wr * 64 + fr; asm volatile("" : "+v"(rcur));
#pragma unroll
        for (int bj = 0; bj < 2; ++bj) cur[bj] = *(const u32x4*)(xb + (rowbase + rcur) * DM + col0 + bj * HALF);
#pragma unroll
        for (int rg = 0; rg < 8; ++rg) {
            const int ai = rg >> 2, m = rg & 3;
            if (rg < 7) { rnxt = ((rg + 1) >> 2) * HALF + wr * 64 + ((rg + 1) & 3) * 16 + fr; asm volatile("" : "+v"(rnxt));
#pragma unroll
                for (int bj = 0; bj < 2; ++bj) nxt[bj] = *(const u32x4*)(xb + (rowbase + rnxt) * DM + col0 + bj * HALF); }
            const size_t off = (rowbase + rcur) * DM + col0;
            float ss = 0.f;
#pragma unroll
            for (int bj = 0; bj < 2; ++bj) {
                const u32x4 c = cur[bj];
                const f32x4 b0 = {__builtin_bit_cast(float, c.x << 16), __builtin_bit_cast(float, c.x & 0xffff0000u), __builtin_bit_cast(float, c.y << 16), __builtin_bit_cast(float, c.y & 0xffff0000u)};
                const f32x4 b1 = {__builtin_bit_cast(float, c.z << 16), __builtin_bit_cast(float, c.z & 0xffff0000u), __builtin_bit_cast(float, c.w << 16), __builtin_bit_cast(float, c.w & 0xffff0000u)};
                const f32x4 x0 = b0 + g[bj][0] * acc[ai][bj][m][0], x1 = b1 + g[bj][1] * acc[ai][bj][m][1];
                if (fin) { *(f32x4*)(fout + off + bj * HALF) = x0; *(f32x4*)(fout + off + bj * HALF + 4) = x1; }
                else { u32x4 w; w.x = cvt_pk_bf16(x0[0], x0[1]); w.y = cvt_pk_bf16(x0[2], x0[3]); w.z = cvt_pk_bf16(x1[0], x1[1]); w.w = cvt_pk_bf16(x1[2], x1[3]); *(u32x4*)(xb + off + bj * HALF) = w; }
                if (xn) { ss += ((x0[0] * x0[0] + x0[1] * x0[1]) + (x0[2] * x0[2] + x0[3] * x0[3])) + ((x1[0] * x1[0] + x1[1] * x1[1]) + (x1[2] * x1[2] + x1[3] * x1[3]));
                    const f32x4 y0 = x0 * gmv[bj][0], y1 = x1 * gmv[bj][1];
                    u32x4 w; w.x = cvt_pk_bf16(y0[0], y0[1]); w.y = cvt_pk_bf16(y0[2], y0[3]); w.z = cvt_pk_bf16(y1[0], y1[1]); w.w = cvt_pk_bf16(y1[2], y1[3]);
                    *(u32x4*)(xnp + off + bj * HALF) = w; }
            }
            if (xn) { ss += __shfl_xor(ss, 16); ss += __shfl_xor(ss, 32); if (fq == 0) __hip_atomic_fetch_add(ssqp + rowbase + rcur, ss, __ATOMIC_RELAXED, __HIP_MEMORY_SCOPE_AGENT); }
            if (rg < 7) { rcur = rnxt; cur[0] = nxt[0]; cur[1] = nxt[1]; }
        }
    }
};
struct EpiInproj {
    static constexpr bool PERM = true, AFTER_DRAIN = false;
    struct Pre { float q[4]; };
    __device__ __forceinline__ void prefetch(const Unit& u, int wr, int fr, Pre& p) const {
        const int row0 = u.pm * BM + wr * 64 + fr;
#pragma unroll
        for (int j = 0; j < 4; ++j) p.q[j] = ssqp[row0 + j * 16];
    }
    bf16_t* P; float* G; const float* bgf; const float* bgb; const float* ssqp; const float* bias;
    __device__ __forceinline__ void operator()(const f32x4 (&acc)[2][2][4][2], const Unit& u, int wr, int wc, int fr, int fq, const Pre& pre) const {
        const int row0 = u.pm * BM + wr * 64 + fr;
        const int s = u.pm < (NLAT / BM) ? (u.pm >> 5) : 8;
        const float* bp = bias + (size_t)s * BIASN + u.pn * BM + wc * 32 + 8 * fq;
        f32x4 bv[2][2];
#pragma unroll
        for (int bj = 0; bj < 2; ++bj) { bv[bj][0] = *(const f32x4*)(bp + bj * HALF); bv[bj][1] = *(const f32x4*)(bp + bj * HALF + 4); }
        if (u.pn == 3) {
            const int c0 = wc * 32 + 8 * fq;
            bv[0][0] += *(const f32x4*)(bgf + c0); bv[0][1] += *(const f32x4*)(bgf + c0 + 4); bv[1][0] += *(const f32x4*)(bgb + c0); bv[1][1] += *(const f32x4*)(bgb + c0 + 4);
        }
#pragma unroll
        for (int ai = 0; ai < 2; ++ai)
#pragma unroll
            for (int m = 0; m < 4; ++m) {
                const int row = row0 + ai * HALF + m * 16;
                const float rstd = rsqrtf((ai == 0 ? pre.q[m] : ssqp[row]) * (1.0f / DM) + EPS);
                if (u.pn == 3) {
                    const int c0 = wc * 32 + 8 * fq;
#pragma unroll
                    for (int bj = 0; bj < 2; ++bj) {
                        float* gp = G + (size_t)row * 256 + bj * HALF + c0;
                        const f32x4 v0 = acc[ai][bj][m][0] * rstd + bv[bj][0], v1 = acc[ai][bj][m][1] * rstd + bv[bj][1]; f32x4 o0, o1;
#pragma unroll
                        for (int i = 0; i < 4; ++i) {
                            o0[i] = (fminf(v0[i], 0.f) - __logf(1.0f + __expf(-fabsf(v0[i])))) * 0.0625f;
                            o1[i] = (fminf(v1[i], 0.f) - __logf(1.0f + __expf(-fabsf(v1[i])))) * 0.0625f;
                        }
                        *(f32x4*)gp = o0; *(f32x4*)(gp + 4) = o1;
                    }
                } else {
                    bf16_t* rowp = P + (size_t)row * NPROJ + u.pn * BM + wc * 32 + 8 * fq;
#pragma unroll
                    for (int bj = 0; bj < 2; ++bj) {
                        const f32x4 v0 = acc[ai][bj][m][0] * rstd + bv[bj][0], v1 = acc[ai][bj][m][1] * rstd + bv[bj][1];
                        u32x4 w; w.x = cvt_pk_bf16(v0[0], v0[1]); w.y = cvt_pk_bf16(v0[2], v0[3]); w.z = cvt_pk_bf16(v1[0], v1[1]); w.w = cvt_pk_bf16(v1[2], v1[3]);
                        *(u32x4*)(rowp + bj * HALF) = w;
                    }
                }
            }
    }
};
}

__device__ __forceinline__ void transpose_item(const float* W, int K, int N, bf16_t* WT, int k0, int n0, int drow0, LAS float* scr, int lane) {
#pragma unroll 8
    for (int i = 0; i < 32; ++i) { const int kk = 2 * i + (lane >> 5); scr[kk * 33 + (lane & 31)] = W[(size_t)(k0 + kk) * N + n0 + (lane & 31)]; }
    asm volatile("s_waitcnt lgkmcnt(0)" ::: "memory");
    const int c = lane & 7;
#pragma unroll
    for (int j = 0; j < 4; ++j) { const int n = (lane >> 3) + 8 * j; const LAS float* s = scr + (8 * c) * 33 + n;
        u32x4 o; o.x = pk2(s[0 * 33], s[1 * 33]); o.y = pk2(s[2 * 33], s[3 * 33]); o.z = pk2(s[4 * 33], s[5 * 33]); o.w = pk2(s[6 * 33], s[7 * 33]);
        *(u32x4*)(WT + (size_t)(drow0 + n) * K + k0 + 8 * c) = o; }
    asm volatile("s_waitcnt lgkmcnt(0)" ::: "memory");
}

__device__ __forceinline__ void prologue_phase(const Args& a, LAS unsigned char* lds) {
    const int tid = opaque_tid(), lane = tid & 63, wave = __builtin_amdgcn_readfirstlane(tid >> 6), G = gridDim.x, bidx = opaque_bid();
    const int gw = bidx * 8 + wave, NGW = G * 8;
    unsigned char* ws = a.ws;
    LAS float* scr = (LAS float*)(lds + wave * 16384);
    for (int l = 0; l < 2; ++l) {
        bf16_t* wl = (bf16_t*)(ws + WS_W + (size_t)l * W_LAYER);
        for (int f = 0; f < 2; ++f) {
            const float* W = a.in[f == 0 ? 7 : 23] + (size_t)l * DM * 2 * FH; bf16_t* WT = (bf16_t*)((unsigned char*)wl + (f == 0 ? WO_F1I : WO_F2I));
            const int nblk = 2 * FH / 32, nitem = (DM / 64) * nblk;
            for (int it = gw; it < nitem; it += NGW) { const int kb = it / nblk, nb = it % nblk, n0 = nb * 32;
                const int hf = n0 >= FH ? 1 : 0, np = n0 - hf * FH; const int drow0 = 256 * (np / 128) + 128 * hf + (np % 128);
                transpose_item(W, DM, 2 * FH, WT, kb * 64, n0, drow0, scr, lane); }
            const float* W2 = a.in[f == 0 ? 8 : 24] + (size_t)l * FH * DM; bf16_t* WT2 = (bf16_t*)((unsigned char*)wl + (f == 0 ? WO_F1O : WO_F2O));
            const int nblk2 = DM / 32, nitem2 = (FH / 64) * nblk2;
            for (int it = gw; it < nitem2; it += NGW) { const int kb = it / nblk2, nb = it % nblk2; transpose_item(W2, FH, DM, WT2, kb * 64, nb * 32, nb * 32, scr, lane); }
        }
        {
            const float* W = a.in[10] + (size_t)l * DM * 2080; bf16_t* WT = (bf16_t*)((unsigned char*)wl + WO_MI);
            const int nblk = 2080 / 32, nitem = (DM / 64) * nblk;
            for (int it = gw; it < nitem; it += NGW) { const int kb = it / nblk, nb = it % nblk, n0 = nb * 32; if (n0 == 768) continue;
                transpose_item(W, DM, 2080, WT, kb * 64, n0, n0 < 768 ? n0 : n0 + 224, scr, lane); }
            const float* wgf = a.in[12] + (size_t)l * 16 * 128; const float* wgb = a.in[14] + (size_t)l * 16 * 128;
            for (int idx = bidx * 512 + tid; idx < 256 * DM; idx += G * 512) { const int k = idx & (DM - 1), n = idx >> 10, dir = n >> 7, nn = n & 127;
                const float* wr = W + (size_t)k * 2080 + 768 + 16 * dir; const float* wg = (dir ? wgb : wgf) + nn; float s = 0.f;
#pragma unroll
                for (int r = 0; r < 16; ++r) s += wr[r] * wg[r * 128];
                WT[(size_t)(768 + n) * DM + k] = (bf16_t)f2bf(s); }
            const float* Wo = a.in[11] + (size_t)l * DM * DM; bf16_t* WTo = (bf16_t*)((unsigned char*)wl + WO_MO);
            const int nblk2 = DM / 32, nitem2 = (DM / 64) * nblk2;
            for (int it = gw; it < nitem2; it += NGW) { const int kb = it / nblk2, nb = it % nblk2; transpose_item(Wo, DM, DM, WTo, kb * 64, nb * 32, nb * 32, scr, lane); }
        }
    }
    {
        float* rope = (float*)(ws + WS_ROPE);
        for (int idx = bidx * 512 + tid; idx < SEQL * 32; idx += G * 512) { const int t = idx >> 5, i = idx & 31, fi = i & 15;
            const float inv = powf(10000.0f, -(float)fi / 16.0f); const float pos = (float)(i < 16 ? (t >> 6) : (t & 63)); const float ang = pos * inv;
            rope[t * 64 + i] = cosf(ang); rope[t * 64 + 32 + i] = sinf(ang); }
    }
    __syncthreads();
    {
        LAS float* sc = (LAS float*)lds;
        LAS float* red = (LAS float*)(lds + 9 * 1024 * 4);
        for (int i = tid; i < 9 * DM; i += 512) { const int s = i >> 10, k = i & (DM - 1); const float v = s < 8 ? a.in[1][s * DM + k] : a.in[3][k]; sc[i] = v / (1.0f + __expf(-v)); }
        __syncthreads();
        float* MOD = (float*)(ws + WS_MOD);
        const int nunit = 2 * (MODW / 64);
        for (int un = bidx; un < nunit; un += G) { const int l = un / (MODW / 64), cgp = un % (MODW / 64), col = cgp * 64 + lane;
            const float* mw = a.in[4] + (size_t)l * DM * MODW + col; float acc[9];
#pragma unroll
            for (int s = 0; s < 9; ++s) acc[s] = 0.f;
            const int kbeg = wave * 128;
#pragma unroll 8
            for (int k = kbeg; k < kbeg + 128; ++k) { const float w = mw[(size_t)k * MODW];
#pragma unroll
                for (int s = 0; s < 9; ++s) acc[s] += sc[s * DM + k] * w; }
#pragma unroll
            for (int s = 0; s < 9; ++s) red[(wave * 9 + s) * 64 + lane] = acc[s];
            __syncthreads();
            for (int i = tid; i < 9 * 64; i += 512) { const int s = i >> 6, ln = i & 63; float t = 0.f;
#pragma unroll
                for (int w = 0; w < 8; ++w) t += red[(w * 9 + s) * 64 + ln];
                MOD[((size_t)l * 9 + s) * MODW + cgp * 64 + ln] = t + a.in[5][(size_t)l * MODW + cgp * 64 + ln]; }
            __syncthreads();
        }
    }
}

__device__ __forceinline__ void norm_phase(const float* xlat, const float* xctx, bf16_t* xn, bf16_t* xb, const float* gain, const float* mod0, float* ssqp, int nrows) {
    const int tid = opaque_tid(), lane = tid & 63, wave = tid >> 6;
    const int gwv = opaque_bid() * 8 + wave, NGW = gridDim.x * 8;
    for (int row = gwv; row < nrows; row += NGW) {
        const bool lat = row < NLAT; const int s = lat ? (row >> 13) : 8;
        const float* xr = lat ? xlat + (size_t)row * DM : xctx + (size_t)(row - NLAT) * DM;
        const float* scl = mod0 + (size_t)s * MODW + DM;
        f32x4 v[4]; float ss = 0.f;
#pragma unroll
        for (int j = 0; j < 4; ++j) { v[j] = *(const f32x4*)(xr + 4 * (lane + 64 * j)); ss += (v[j][0] * v[j][0] + v[j][1] * v[j][1]) + (v[j][2] * v[j][2] + v[j][3] * v[j][3]); }
        ss = wave_sum(ss);
        if (lane == 0) ssqp[row] = ss;
#pragma unroll
        for (int j = 0; j < 4; ++j) { const int c = 4 * (lane + 64 * j);
            const f32x4 y = v[j] * (*(const f32x4*)(gain + c) * (*(const f32x4*)(scl + c) + 1.0f));
            u32x2 w; w.x = pk2(y[0], y[1]); w.y = pk2(y[2], y[3]);
            *(u32x2*)(xn + (size_t)row * DM + c) = w;
            u32x2 wx; wx.x = pk2(v[j][0], v[j][1]); wx.y = pk2(v[j][2], v[j][3]);
            *(u32x2*)(xb + (size_t)row * DM + c) = wx; }
    }
}

__device__ __forceinline__ void bias_phase(const Args& a) {
    const int tid = opaque_tid(), lane = tid & 63, wave = tid >> 6, bidx = opaque_bid(), G = gridDim.x;
    unsigned char* ws = a.ws; const float* MOD = (const float*)(ws + WS_MOD); float* GM = (float*)(ws + WS_GM); float* BIAS = (float*)(ws + WS_BIAS);
    for (int idx = bidx * 512 + tid; idx < 2 * 3 * 9 * DM; idx += G * 512) { const int c = idx & (DM - 1), s = (idx >> 10) % 9, w = (idx / (9 * DM)) % 3, l = idx / (27 * DM);
        const float* gn = a.in[w == 0 ? 6 : w == 1 ? 9 : 22] + l * DM;
        GM[idx] = gn[c] * (1.0f + MOD[((size_t)l * 9 + s) * MODW + (3 * w + 1) * DM + c]); }
    const int NR = 2 * FH + NPROJ + 2 * FH;
    for (int r = bidx * 8 + wave; r < 2 * NR; r += G * 8) { const int l = r / NR; int n = r % NR; int w = 0; if (n >= 2 * FH) { n -= 2 * FH; w = 1; if (n >= NPROJ) { n -= NPROJ; w = 2; } }
        const bf16_t* Wt = (const bf16_t*)(ws + WS_W + (size_t)l * W_LAYER + (w == 0 ? WO_F1I : w == 1 ? WO_MI : WO_F2I)) + (size_t)n * DM + 16 * lane;
        const bf16x8 w0 = *(const bf16x8*)Wt, w1 = *(const bf16x8*)(Wt + 8); float wf[16];
#pragma unroll
        for (int j = 0; j < 8; ++j) { wf[j] = bf2f((unsigned short)w0[j]); wf[8 + j] = bf2f((unsigned short)w1[j]); }
        for (int s = 0; s < 9; ++s) { const float* sh = MOD + ((size_t)l * 9 + s) * MODW + (3 * w) * DM + 16 * lane; float t = 0.f;
#pragma unroll
            for (int q = 0; q < 4; ++q) { const f32x4 x = *(const f32x4*)(sh + 4 * q); t += (x[0] * wf[4 * q] + x[1] * wf[4 * q + 1]) + (x[2] * wf[4 * q + 2] + x[3] * wf[4 * q + 3]); }
            t = wave_sum(t);
            if (lane == 0) BIAS[(((size_t)l * 3 + w) * 9 + s) * BIASN + n] = t; }
    }
}

__device__ __forceinline__ void prep_unit(int un, bf16_t* PROJ, bf16_t* VT, bf16_t* KT, const float* rope, const float* gqg, const float* gkg, const float* wqg, const float* wkg, LAS unsigned char* lds) {
    const int tid = opaque_tid(), lane = tid & 63, wave = tid >> 6;
    const int R0 = un * 64; const bool lat = R0 < NLAT;
    const int b = lat ? (R0 >> 13) : ((R0 - NLAT) >> 8); const int t0 = lat ? (R0 & (SEQL - 1)) : ((R0 - NLAT) & (NCTX - 1));
    const int kpos0 = lat ? t0 : SEQL + t0;
    const int hh = lane >> 2, sub = lane & 3;
    const int cbase = hh < 8 ? C_GQ + 64 * hh : hh < 10 ? C_GK + 64 * (hh - 8) : hh < 14 ? C_WQ + 64 * (hh - 10) : C_WK + 64 * (hh - 14);
    const float* gain = hh < 8 ? gqg : hh < 10 ? gkg : hh < 14 ? wqg : wkg;
    const bool isq = hh < 8 || (hh >= 10 && hh < 14);
    float g1[8], g2[8];
#pragma unroll
    for (int j = 0; j < 8; ++j) { g1[j] = gain[8 * sub + j]; g2[j] = gain[32 + 8 * sub + j]; }
#pragma unroll
    for (int rr = 0; rr < 8; ++rr) {
        const int r = wave * 8 + rr; bf16_t* p = PROJ + (size_t)(R0 + r) * NPROJ + cbase + 8 * sub;
        const bf16x8 a = *(const bf16x8*)p, c = *(const bf16x8*)(p + 32);
        float x1[8], x2[8]; float ss = 0.f;
#pragma unroll
        for (int j = 0; j < 8; ++j) { x1[j] = bf2f((unsigned short)a[j]); x2[j] = bf2f((unsigned short)c[j]); ss += x1[j] * x1[j] + x2[j] * x2[j]; }
        ss += __shfl_xor(ss, 1); ss += __shfl_xor(ss, 2);
        const float rstd = rsqrtf(ss * (1.0f / 64.0f) + EPS);
#pragma unroll
        for (int j = 0; j < 8; ++j) { x1[j] = x1[j] * rstd * g1[j]; x2[j] = x2[j] * rstd * g2[j]; }
        if (lat) { const float* rp = rope + (size_t)(t0 + r) * 64 + 8 * sub;
#pragma unroll
            for (int j = 0; j < 8; ++j) { const float cs = rp[j], sn = rp[32 + j]; const float y1 = x1[j] * cs - x2[j] * sn, y2 = x1[j] * sn + x2[j] * cs; x1[j] = y1; x2[j] = y2; } }
        const float qs = isq ? QSCALE : 1.0f;
        u32x4 w1, w2;
        w1.x = pk2(x1[0] * qs, x1[1] * qs); w1.y = pk2(x1[2] * qs, x1[3] * qs); w1.z = pk2(x1[4] * qs, x1[5] * qs); w1.w = pk2(x1[6] * qs, x1[7] * qs);
        w2.x = pk2(x2[0] * qs, x2[1] * qs); w2.y = pk2(x2[2] * qs, x2[3] * qs); w2.z = pk2(x2[4] * qs, x2[5] * qs); w2.w = pk2(x2[6] * qs, x2[7] * qs);
        if (isq) { *(u32x4*)p = w1; *(u32x4*)(p + 32) = w2; }
        else { const int ksel = hh >= 14 ? 1 : 0, kvh = ksel ? hh - 14 : hh - 8;
            bf16_t* kd = KT + ((size_t)((b * 2 + ksel) * 2 + kvh) * 132 + (kpos0 >> 6)) * 4096 + r * 64 + 8 * sub;
            *(u32x4*)kd = w1; *(u32x4*)(kd + 32) = w2; }
    }
    LAS bf16_t* vs = (LAS bf16_t*)lds;
    {
        const int r = tid >> 3, ch = tid & 7;
        const bf16_t* src = PROJ + (size_t)(R0 + r) * NPROJ + (ch < 4 ? C_GV + 32 * ch : C_WV + 32 * (ch - 4));
#pragma unroll
        for (int q = 0; q < 4; ++q) { const u32x4 v = *(const u32x4*)(src + 8 * q); LAS unsigned* d = (LAS unsigned*)(vs + r * 264 + ch * 32 + 8 * q); d[0] = v.x; d[1] = v.y; d[2] = v.z; d[3] = v.w; }
    }
    __syncthreads();
    {
        const int dc = tid >> 1, half = tid & 1;
        unsigned w[16];
#pragma unroll
        for (int i = 0; i < 16; ++i) { const unsigned lo = vs[(half * 32 + 2 * i) * 264 + dc], hi = vs[(half * 32 + 2 * i + 1) * 264 + dc]; w[i] = lo | (hi << 16); }
        bf16_t* dst = VT + ((size_t)(b * 4 + (dc >> 6)) * 132 + (kpos0 >> 6)) * 4096 + (dc & 63) * 64 + half * 32;
#pragma unroll
        for (int q = 0; q < 4; ++q) { u32x4 o; o.x = w[4 * q]; o.y = w[4 * q + 1]; o.z = w[4 * q + 2]; o.w = w[4 * q + 3]; *(u32x4*)(dst + 8 * q) = o; }
    }
    __syncthreads();
}

__device__ __forceinline__ int gla_row0(int b, int n) { return n < 4 ? NLAT + b * NCTX + 64 * n : b * SEQL + 64 * (n - 4); }
__device__ __forceinline__ int gla_posb(int n) { return n < 4 ? 3 - n : 135 - n; }

__device__ __forceinline__ void gla_g1_unit(int un, const bf16_t* PROJ, const float* G, float* DS, float* DEC, LAS unsigned char* lds) {
    const int tid = opaque_tid();
    const int bh = un / NCHUNK, n = un % NCHUNK, b = bh >> 2, h = bh & 3, R0 = gla_row0(b, n);
    LAS float* k = (LAS float*)lds;
    LAS float* v = k + 64 * 33;
    LAS float* bf = v + 64 * 64;
    LAS float* bb = bf + 64 * 33;
    LAS float* kf = bb + 64 * 33;
    LAS float* kb = kf + 64 * 33;
    for (int i = tid; i < 64 * 32; i += 512) { const int c = i >> 5, d = i & 31; const size_t row = (size_t)(R0 + c);
        k[c * 33 + d] = bf2f(PROJ[row * NPROJ + C_AK + 32 * h + d]);
        bf[c * 33 + d] = G[row * 256 + 32 * h + d]; bb[c * 33 + d] = G[row * 256 + 128 + 32 * h + d]; }
    for (int i = tid; i < 64 * 64; i += 512) { const int c = i >> 6, d = i & 63; v[i] = bf2f(PROJ[(size_t)(R0 + c) * NPROJ + C_AV + 64 * h + d]); }
    __syncthreads();
    if (tid < 32) { float s = 0.f; for (int c = 0; c < 64; ++c) { s += bf[c * 33 + tid]; bf[c * 33 + tid] = s; } }
    else if (tid < 64) { const int d = tid - 32; float s = 0.f; for (int c = 63; c >= 0; --c) { s += bb[c * 33 + d]; bb[c * 33 + d] = s; } }
    __syncthreads();
    for (int i = tid; i < 64 * 32; i += 512) { const int c = i >> 5, d = i & 31; const float kk = k[c * 33 + d];
        kf[c * 33 + d] = kk * __expf(bf[63 * 33 + d] - bf[c * 33 + d]); kb[c * 33 + d] = kk * __expf(bb[d] - bb[c * 33 + d]); }
    __syncthreads();
    {
        const int vv = tid & 63, dg = tid >> 6; float af[4] = {0.f, 0.f, 0.f, 0.f}, ab[4] = {0.f, 0.f, 0.f, 0.f};
        for (int c = 0; c < 64; ++c) { const float x = v[c * 64 + vv];
#pragma unroll
            for (int j = 0; j < 4; ++j) { af[j] += kf[c * 33 + dg * 4 + j] * x; ab[j] += kb[c * 33 + dg * 4 + j] * x; } }
        float* dsf = DS + ((size_t)(bh * 2 + 0) * NCHUNK + n) * 2048; float* dsb = DS + ((size_t)(bh * 2 + 1) * NCHUNK + gla_posb(n)) * 2048;
#pragma unroll
        for (int j = 0; j < 4; ++j) { dsf[(dg * 4 + j) * 64 + vv] = af[j]; dsb[(dg * 4 + j) * 64 + vv] = ab[j]; }
        if (tid < 32) DEC[((size_t)(bh * 2 + 0) * NCHUNK + n) * 32 + tid] = __expf(bf[63 * 33 + tid]);
        else if (tid < 64) DEC[((size_t)(bh * 2 + 1) * NCHUNK + gla_posb(n)) * 32 + (tid - 32)] = __expf(bb[tid - 32]);
    }
    __syncthreads();
}

__device__ __forceinline__ void gla_scan_chain(int ch, float* DS, const float* DEC) {
    const int tid = opaque_tid(), bd = ch >> 2, e = (ch & 3) * 512 + tid, d = e >> 6;
    float* ds = DS + (size_t)bd * NCHUNK * 2048 + e; const float* dec = DEC + (size_t)bd * NCHUNK * 32 + d;
    float S = 0.f;
    for (int p = 0; p < NCHUNK; p += 22) {
        float t[22], dc[22];
#pragma unroll
        for (int j = 0; j < 22; ++j) { t[j] = ds[(size_t)(p + j) * 2048]; dc[j] = dec[(p + j) * 32]; }
#pragma unroll
        for (int j = 0; j < 22; ++j) { ds[(size_t)(p + j) * 2048] = S; S = dc[j] * S + t[j]; }
    }
}

__device__ __forceinline__ void gla_g3_unit(int un, const bf16_t* PROJ, const float* G, const float* DS, const float* gain, bf16_t* MIX, LAS unsigned char* lds) {
    const int tid = opaque_tid(), lane = tid & 63;
    const int bh = un / NCHUNK, n = un % NCHUNK, b = bh >> 2, h = bh & 3, R0 = gla_row0(b, n);
    LAS float* q = (LAS float*)lds;
    LAS float* k = q + 64 * 33;
    LAS float* bf = k + 64 * 33;
    LAS float* bb = bf + 64 * 33;
    LAS float* qf = bb + 64 * 33;
    LAS float* kif = qf + 64 * 33;
    LAS float* qb = kif + 64 * 33;
    LAS float* kib = qb + 64 * 33;
    LAS float* v = kib + 64 * 33;
    LAS float* Sf = v + 64 * 64;
    LAS float* Sb = Sf + 32 * 64;
    LAS float* A = Sb + 32 * 64;
    for (int i = tid; i < 64 * 32; i += 512) { const int c = i >> 5, d = i & 31; const size_t row = (size_t)(R0 + c);
        q[c * 33 + d] = bf2f(PROJ[row * NPROJ + C_AQ + 32 * h + d]) * 0.17677669529663687f;
        k[c * 33 + d] = bf2f(PROJ[row * NPROJ + C_AK + 32 * h + d]);
        bf[c * 33 + d] = G[row * 256 + 32 * h + d]; bb[c * 33 + d] = G[row * 256 + 128 + 32 * h + d]; }
    for (int i = tid; i < 64 * 64; i += 512) { const int c = i >> 6, d = i & 63; v[i] = bf2f(PROJ[(size_t)(R0 + c) * NPROJ + C_AV + 64 * h + d]); }
    { const float* sf = DS + ((size_t)(bh * 2 + 0) * NCHUNK + n) * 2048; const float* sb = DS + ((size_t)(bh * 2 + 1) * NCHUNK + gla_posb(n)) * 2048;
      for (int i = tid; i < 2048; i += 512) { Sf[i] = sf[i]; Sb[i] = sb[i]; } }
    __syncthreads();
    if (tid < 32) { float s = 0.f; for (int c = 0; c < 64; ++c) { s += bf[c * 33 + tid]; bf[c * 33 + tid] = s; } }
    else if (tid < 64) { const int d = tid - 32; float s = 0.f; for (int c = 63; c >= 0; --c) { s += bb[c * 33 + d]; bb[c * 33 + d] = s; } }
    __syncthreads();
    for (int i = tid; i < 64 * 32; i += 512) { const int c = i >> 5, d = i & 31; const int o = c * 33 + d; const float ef = __expf(bf[o]), eb = __expf(bb[o]);
        qf[o] = q[o] * ef; kif[o] = k[o] / ef; qb[o] = q[o] * eb; kib[o] = k[o] / eb; }
    __syncthreads();
    {
        const int s = lane, cg0 = (tid >> 6) * 8;
#pragma unroll 1
        for (int j = 0; j < 8; ++j) { const int c = cg0 + j; float af = 0.f, ab = 0.f;
            if (s <= c) {
#pragma unroll 8
                for (int d = 0; d < 32; ++d) af += qf[c * 33 + d] * kif[s * 33 + d]; }
            if (s >= c) {
#pragma unroll 8
                for (int d = 0; d < 32; ++d) ab += qb[c * 33 + d] * kib[s * 33 + d]; }
            A[c * 65 + s] = af + ab; }
    }
    __syncthreads();
    {
        const int vv = lane, cg0 = (tid >> 6) * 8; const float gn = gain[vv];
#pragma unroll 1
        for (int j = 0; j < 8; ++j) { const int c = cg0 + j; float o = 0.f;
#pragma unroll 8
            for (int s = 0; s < 64; ++s) o += A[c * 65 + s] * v[s * 64 + vv];
#pragma unroll 8
            for (int d = 0; d < 32; ++d) o += qf[c * 33 + d] * Sf[d * 64 + vv] + qb[c * 33 + d] * Sb[d * 64 + vv];
            const float ms = wave_sum(o * o) * (1.0f / 64.0f);
            const float r = bf2f(PROJ[(size_t)(R0 + c) * NPROJ + C_AR + 64 * h + vv]);
            const float y = o * rsqrtf(ms + EPS) * gn * silu_f(r);
            MIX[(size_t)(R0 + c) * DM + 64 * h + vv] = (bf16_t)f2bf(y); }
    }
    __syncthreads();
}

struct AttnDesc { const bf16_t* Q; bf16_t* O; const bf16_t* Klat; const bf16_t* Kctx; const bf16_t* Vt; int nctx, nloc0, nloc, win, qpos0, has_sink; float sinkl2; };
constexpr int KSTR = 144, VSTR = 136, ABUF = 64 * KSTR + 64 * VSTR;
typedef float f32x2_t __attribute__((ext_vector_type(2))); typedef __bf16 bf16x2_t __attribute__((ext_vector_type(2)));
__device__ __forceinline__ unsigned cvtpk(float lo, float hi) { f32x2_t v = {lo, hi}; bf16x2_t b = __builtin_convertvector(v, bf16x2_t); return __builtin_bit_cast(unsigned, b); }
__device__ __forceinline__ float fadd_s(float a, float b) { float r; asm("v_add_f32_e32 %0, %1, %2" : "=v"(r) : "v"(a), "v"(b)); return r; }
__device__ __forceinline__ float max3f(float a, float b, float c) { return __builtin_fmaxf(__builtin_fmaxf(a, b), c); }
__device__ __forceinline__ int crow(int r, int hi) { return (r & 3) + 8 * (r >> 2) + 4 * hi; }

__device__ __forceinline__ void attn_unit(const AttnDesc& u, LAS unsigned char* lds) {
    const int tid = opaque_tid(), lane = tid & 63, r32 = lane & 31, hi = lane >> 5, wid = tid >> 6;
    const bf16_t* Qw = u.Q + (size_t)(wid * 32 + r32) * NPROJ;
    bf16x8 qr[4];
#pragma unroll
    for (int d0 = 0; d0 < 4; ++d0) qr[d0] = *(const bf16x8*)(Qw + d0 * 16 + hi * 8);
#pragma unroll
    for (int d0 = 0; d0 < 4; ++d0) asm volatile("" : "+v"(qr[d0]));
    f32x16 o0, o1, negm;
#pragma unroll
    for (int r = 0; r < 16; ++r) { o0[r] = 0.f; o1[r] = 0.f; negm[r] = 0.f; }
    float mhat = 0.f, lsum = 0.f;
    const int ntile = u.nctx + u.nloc;
    const int srow = tid >> 3, sch = tid & 7;
    u32x4 kreg, vreg;
#define ATT_LOAD(i) do { const int T_ = (i) < u.nctx ? 128 + (i) : u.nloc0 + ((i) - u.nctx); \
        kreg = *(const u32x4*)(u.Klat + (size_t)T_ * 4096 + srow * 64 + sch * 8); vreg = *(const u32x4*)(u.Vt + (size_t)T_ * 4096 + srow * 64 + sch * 8); } while (0)
#define ATT_STORE(buf) do { LAS unsigned char* kb_ = lds + (buf) * ABUF; *(LAS u32x4*)(kb_ + srow * KSTR + sch * 16) = kreg; \
        LAS u32x2* vd_ = (LAS u32x2*)(kb_ + 64 * KSTR + srow * VSTR + sch * 16); vd_[0] = (u32x2){vreg.x, vreg.y}; vd_[1] = (u32x2){vreg.z, vreg.w}; } while (0)
    ATT_LOAD(0); ATT_STORE(0);
    __syncthreads();
    for (int i = 0; i < ntile; ++i) {
        if (i + 1 < ntile) ATT_LOAD(i + 1);
        const LAS unsigned char* Kl = lds + (i & 1) * ABUF; const LAS unsigned char* Vl = Kl + 64 * KSTR;
        f32x16 p0, p1;
#pragma unroll
        for (int d0 = 0; d0 < 4; ++d0) {
            const bf16x8 k0 = *(const LAS bf16x8*)(Kl + r32 * KSTR + d0 * 32 + hi * 16), k1 = *(const LAS bf16x8*)(Kl + (r32 + 32) * KSTR + d0 * 32 + hi * 16);
            if (d0 == 0) { p0 = __builtin_amdgcn_mfma_f32_32x32x16_bf16(k0, qr[0], negm, 0, 0, 0); p1 = __builtin_amdgcn_mfma_f32_32x32x16_bf16(k1, qr[0], negm, 0, 0, 0); }
            else { p0 = __builtin_amdgcn_mfma_f32_32x32x16_bf16(k0, qr[d0], p0, 0, 0, 0); p1 = __builtin_amdgcn_mfma_f32_32x32x16_bf16(k1, qr[d0], p1, 0, 0, 0); }
        }
        const int T = i < u.nctx ? 128 + i : u.nloc0 + (i - u.nctx);
        if (u.win && T < 128) {
            const int qpos = u.qpos0 + wid * 32 + r32, kb = 64 * T - qpos;
#pragma unroll
            for (int r = 0; r < 16; ++r) { const int rel = kb + crow(r, hi); if (rel < -128 || rel > 128) p0[r] = -INFINITY; if (rel + 32 < -128 || rel + 32 > 128) p1[r] = -INFINITY; }
        }
        float rm = max3f(p0[0], p1[0], p0[1]), rm2 = max3f(p1[1], p0[2], p1[2]);
#pragma unroll
        for (int r = 3; r < 15; r += 2) { rm = max3f(rm, p0[r], p1[r]); rm2 = max3f(rm2, p0[r + 1], p1[r + 1]); }
        rm = max3f(rm, p0[15], p1[15]); rm = fmaxf(rm, rm2);
        rm = fmaxf(rm, __shfl_xor(rm, 32));
        if (i == 0) {
            mhat = rm;
#pragma unroll
            for (int r = 0; r < 16; ++r) { p0[r] -= rm; p1[r] -= rm; negm[r] = -mhat; }
        } else if (__any(rm > 8.0f)) {
            const float dl = fmaxf(rm, 0.f); mhat += dl; const float f = __builtin_amdgcn_exp2f(-dl); lsum *= f;
#pragma unroll
            for (int r = 0; r < 16; ++r) { p0[r] -= dl; p1[r] -= dl; negm[r] = -mhat; o0[r] *= f; o1[r] *= f; }
        }
        float ps = 0.f;
#pragma unroll
        for (int r = 0; r < 16; ++r) { p0[r] = __builtin_amdgcn_exp2f(p0[r]); p1[r] = __builtin_amdgcn_exp2f(p1[r]); ps += p0[r] + p1[r]; }
        lsum += ps;
        u32x4 pw[4];
        pw[0] = (u32x4){cvtpk(p0[0], p0[1]), cvtpk(p0[2], p0[3]), cvtpk(p0[4], p0[5]), cvtpk(p0[6], p0[7])};
        pw[1] = (u32x4){cvtpk(p0[8], p0[9]), cvtpk(p0[10], p0[11]), cvtpk(p0[12], p0[13]), cvtpk(p0[14], p0[15])};
        pw[2] = (u32x4){cvtpk(p1[0], p1[1]), cvtpk(p1[2], p1[3]), cvtpk(p1[4], p1[5]), cvtpk(p1[6], p1[7])};
        pw[3] = (u32x4){cvtpk(p1[8], p1[9]), cvtpk(p1[10], p1[11]), cvtpk(p1[12], p1[13]), cvtpk(p1[14], p1[15])};
#pragma unroll
        for (int ks = 0; ks < 4; ++ks) {
            const bf16x8 pa = __builtin_bit_cast(bf16x8, pw[ks]);
            const LAS unsigned char* vp = Vl + r32 * VSTR + (16 * ks + 4 * hi) * 2;
            const s16x4 a0 = *(const LAS s16x4*)vp, a1 = *(const LAS s16x4*)(vp + 16);
            const s16x4 c0 = *(const LAS s16x4*)(vp + 32 * VSTR), c1 = *(const LAS s16x4*)(vp + 32 * VSTR + 16);
            const bf16x8 v0 = (bf16x8){a0[0], a0[1], a0[2], a0[3], a1[0], a1[1], a1[2], a1[3]}, v1 = (bf16x8){c0[0], c0[1], c0[2], c0[3], c1[0], c1[1], c1[2], c1[3]};
            o0 = __builtin_amdgcn_mfma_f32_32x32x16_bf16(v0, pa, o0, 0, 0, 0);
            o1 = __builtin_amdgcn_mfma_f32_32x32x16_bf16(v1, pa, o1, 0, 0, 0);
        }
        if (i + 1 < ntile) ATT_STORE((i + 1) & 1);
        __syncthreads();
    }
#undef ATT_LOAD
#undef ATT_STORE
    float lt = lsum + __shfl_xor(lsum, 32);
    if (u.has_sink) lt += __builtin_amdgcn_exp2f(u.sinkl2 - mhat);
    const float inv = 1.0f / lt;
    bf16_t* Ow = u.O + (size_t)(wid * 32 + r32) * DM;
#pragma unroll
    for (int g = 0; g < 4; ++g) {
        u32x2 w0, w1;
        w0.x = pk2(o0[4 * g] * inv, o0[4 * g + 1] * inv); w0.y = pk2(o0[4 * g + 2] * inv, o0[4 * g + 3] * inv);
        w1.x = pk2(o1[4 * g] * inv, o1[4 * g + 1] * inv); w1.y = pk2(o1[4 * g + 2] * inv, o1[4 * g + 3] * inv);
        *(u32x2*)(Ow + 8 * g + 4 * hi) = w0; *(u32x2*)(Ow + 32 + 8 * g + 4 * hi) = w1;
    }
}


constexpr int GL_SLOT = 24576, GL_QB = 0, GL_KB = 5120, GL_VT = 10240, GL_ST = 18944;
__device__ __forceinline__ float wave_scan_incl(float v, int lane) {
#pragma unroll
    for (int o = 1; o < 64; o <<= 1) { const float t = __shfl_up(v, o); v = lane >= o ? v + t : v; }
    return v;
}
__device__ __forceinline__ bf16x8 lds_rd2x64(const LAS unsigned char* p) { const s16x4 a = *(const LAS s16x4*)p, b = *(const LAS s16x4*)(p + 8); return (bf16x8){a[0], a[1], a[2], a[3], b[0], b[1], b[2], b[3]}; }

__device__ __forceinline__ void gla_g1_mfma(int grp, const bf16_t* PROJ, const float* G, float* DS, float* DEC, LAS unsigned char* lds) {
    const int tid = opaque_tid(), lane = tid & 63, wave = tid >> 6, slot = wave >> 1, m = wave & 1, r32 = lane & 31, hi = lane >> 5;
    const int bh = grp / 33, n = (grp % 33) * 4 + slot, b = bh >> 2, h = bh & 3, R0 = gla_row0(b, n), posb = gla_posb(n);
    LAS unsigned char* sl = lds + slot * GL_SLOT;
    const bf16_t* pr = PROJ + (size_t)(R0 + lane) * NPROJ; const float* gr = G + (size_t)(R0 + lane) * 256 + 32 * h + 16 * m;
    const bf16x8 kv0 = *(const bf16x8*)(pr + C_AK + 32 * h + 16 * m), kv1 = *(const bf16x8*)(pr + C_AK + 32 * h + 16 * m + 8);
    float gf[16], gb[16], kk[16];
#pragma unroll
    for (int i = 0; i < 4; ++i) { const f32x4 a = *(const f32x4*)(gr + 4 * i), c = *(const f32x4*)(gr + 128 + 4 * i);
#pragma unroll
        for (int j = 0; j < 4; ++j) { gf[4 * i + j] = a[j]; gb[4 * i + j] = c[j]; } }
#pragma unroll
    for (int j = 0; j < 8; ++j) { kk[j] = bf2f((unsigned short)kv0[j]); kk[8 + j] = bf2f((unsigned short)kv1[j]); }
#pragma unroll
    for (int i = 0; i < 4; ++i) { const bf16x8 v8 = *(const bf16x8*)(pr + C_AV + 64 * h + 32 * m + 8 * i);
#pragma unroll
        for (int j = 0; j < 8; ++j) *(LAS bf16_t*)(sl + GL_VT + (32 * m + 8 * i + j) * 136 + 2 * lane) = (bf16_t)v8[j]; }
#pragma unroll
    for (int i = 0; i < 16; ++i) {
        const float bf = wave_scan_incl(gf[i], lane); const float t = wave_scan_incl(gb[i], lane); const float bb = __shfl(t, 63) - t + gb[i];
        const float gamf = __shfl(bf, 63), gamb = __shfl(bb, 0);
        *(LAS bf16_t*)(sl + GL_QB + (16 * m + i) * 136 + 2 * lane) = (bf16_t)f2bf(kk[i] * __expf(gamf - bf));
        *(LAS bf16_t*)(sl + GL_KB + (16 * m + i) * 136 + 2 * lane) = (bf16_t)f2bf(kk[i] * __expf(gamb - bb));
        if (lane == 63) DEC[((size_t)(bh * 2 + 0) * NCHUNK + n) * 32 + 16 * m + i] = __expf(bf);
        if (lane == 0) DEC[((size_t)(bh * 2 + 1) * NCHUNK + posb) * 32 + 16 * m + i] = __expf(bb);
    }
    __syncthreads();
    {
        const LAS unsigned char* KT = sl + (m == 0 ? GL_QB : GL_KB);
        f32x16 acc0, acc1;
#pragma unroll
        for (int r = 0; r < 16; ++r) { acc0[r] = 0.f; acc1[r] = 0.f; }
#pragma unroll
        for (int ks = 0; ks < 4; ++ks) {
            const bf16x8 bfr = lds_rd2x64(KT + r32 * 136 + (16 * ks + 8 * hi) * 2);
            const bf16x8 a0 = lds_rd2x64(sl + GL_VT + r32 * 136 + (16 * ks + 8 * hi) * 2), a1 = lds_rd2x64(sl + GL_VT + (32 + r32) * 136 + (16 * ks + 8 * hi) * 2);
            acc0 = __builtin_amdgcn_mfma_f32_32x32x16_bf16(a0, bfr, acc0, 0, 0, 0); acc1 = __builtin_amdgcn_mfma_f32_32x32x16_bf16(a1, bfr, acc1, 0, 0, 0);
        }
        float* dst = DS + ((size_t)(bh * 2 + m) * NCHUNK + (m == 0 ? n : posb)) * 2048 + r32 * 64;
#pragma unroll
        for (int g = 0; g < 4; ++g) {
            *(f32x4*)(dst + 8 * g + 4 * hi) = (f32x4){acc0[4 * g], acc0[4 * g + 1], acc0[4 * g + 2], acc0[4 * g + 3]};
            *(f32x4*)(dst + 32 + 8 * g + 4 * hi) = (f32x4){acc1[4 * g], acc1[4 * g + 1], acc1[4 * g + 2], acc1[4 * g + 3]};
        }
    }
    __syncthreads();
}

__device__ __forceinline__ void gla_g3_mfma(int grp, const bf16_t* PROJ, const float* G, const float* DS, const float* gain, bf16_t* MIX, LAS unsigned char* lds) {
    const int tid = opaque_tid(), lane = tid & 63, wave = tid >> 6, slot = wave >> 1, m = wave & 1, r32 = lane & 31, hi = lane >> 5;
    const int bh = grp / 33, n = (grp % 33) * 4 + slot, b = bh >> 2, h = bh & 3, R0 = gla_row0(b, n), posb = gla_posb(n);
    LAS unsigned char* sl = lds + slot * GL_SLOT;
    const bf16_t* pr = PROJ + (size_t)(R0 + lane) * NPROJ; const float* gr = G + (size_t)(R0 + lane) * 256 + 32 * h + 16 * m;
    const bf16x8 qv0 = *(const bf16x8*)(pr + C_AQ + 32 * h + 16 * m), qv1 = *(const bf16x8*)(pr + C_AQ + 32 * h + 16 * m + 8);
    const bf16x8 kv0 = *(const bf16x8*)(pr + C_AK + 32 * h + 16 * m), kv1 = *(const bf16x8*)(pr + C_AK + 32 * h + 16 * m + 8);
    s16x4 rga[4], rgb[4];
    { const bf16_t* rp0 = PROJ + (size_t)(R0 + 32 * m + r32) * NPROJ + C_AR + 64 * h;
#pragma unroll
      for (int g = 0; g < 4; ++g) { rga[g] = *(const s16x4*)(rp0 + 8 * g + 4 * hi); rgb[g] = *(const s16x4*)(rp0 + 32 + 8 * g + 4 * hi); } }
    float bf[16], bb[16], qq[16], kk[16];
#pragma unroll
    for (int i = 0; i < 4; ++i) { const f32x4 a = *(const f32x4*)(gr + 4 * i), c = *(const f32x4*)(gr + 128 + 4 * i);
#pragma unroll
        for (int j = 0; j < 4; ++j) { bf[4 * i + j] = a[j]; bb[4 * i + j] = c[j]; } }
#pragma unroll
    for (int j = 0; j < 8; ++j) { qq[j] = bf2f((unsigned short)qv0[j]) * 0.17677669529663687f; qq[8 + j] = bf2f((unsigned short)qv1[j]) * 0.17677669529663687f; kk[j] = bf2f((unsigned short)kv0[j]); kk[8 + j] = bf2f((unsigned short)kv1[j]); }
#pragma unroll
    for (int i = 0; i < 4; ++i) { const bf16x8 v8 = *(const bf16x8*)(pr + C_AV + 64 * h + 32 * m + 8 * i);
#pragma unroll
        for (int j = 0; j < 8; ++j) *(LAS bf16_t*)(sl + GL_VT + (32 * m + 8 * i + j) * 136 + 2 * lane) = (bf16_t)v8[j]; }
    const float* sfp = DS + ((size_t)(bh * 2 + 0) * NCHUNK + n) * 2048 + (16 * m) * 64 + lane; const float* sbp = DS + ((size_t)(bh * 2 + 1) * NCHUNK + posb) * 2048 + (16 * m) * 64 + lane;
    float sfv[16], sbv[16];
#pragma unroll
    for (int i = 0; i < 16; ++i) { sfv[i] = sfp[i * 64]; sbv[i] = sbp[i * 64]; }
#pragma unroll
    for (int i = 0; i < 16; ++i) { bf[i] = wave_scan_incl(bf[i], lane); const float g0 = bb[i]; const float t = wave_scan_incl(g0, lane); bb[i] = __shfl(t, 63) - t + g0; }
    {
        unsigned wq[8], wk[8], wsx[8];
#pragma unroll
        for (int i = 0; i < 8; ++i) { const float e0 = __expf(bf[2 * i]), e1 = __expf(bf[2 * i + 1]), i0 = __expf(-bf[2 * i]), i1 = __expf(-bf[2 * i + 1]);
            wq[i] = cvtpk(qq[2 * i] * e0, qq[2 * i + 1] * e1); wk[i] = cvtpk(kk[2 * i] * i0, kk[2 * i + 1] * i1); wsx[i] = cvtpk(sfv[2 * i], sfv[2 * i + 1]); }
        LAS u32x4* dq = (LAS u32x4*)(sl + GL_QB + lane * 80 + 32 * m); dq[0] = (u32x4){wq[0], wq[1], wq[2], wq[3]}; dq[1] = (u32x4){wq[4], wq[5], wq[6], wq[7]};
        LAS u32x4* dk = (LAS u32x4*)(sl + GL_KB + lane * 80 + 32 * m); dk[0] = (u32x4){wk[0], wk[1], wk[2], wk[3]}; dk[1] = (u32x4){wk[4], wk[5], wk[6], wk[7]};
        LAS u32x4* dsx = (LAS u32x4*)(sl + GL_ST + lane * 80 + 32 * m); dsx[0] = (u32x4){wsx[0], wsx[1], wsx[2], wsx[3]}; dsx[1] = (u32x4){wsx[4], wsx[5], wsx[6], wsx[7]};
    }
    __syncthreads();
    f32x16 P0, P1, O0, O1;
#pragma unroll
    for (int r = 0; r < 16; ++r) { P0[r] = 0.f; P1[r] = 0.f; O0[r] = 0.f; O1[r] = 0.f; }
    const int cloc = 32 * m + r32;
    {
        bf16x8 qfr[2];
#pragma unroll
        for (int kq = 0; kq < 2; ++kq) qfr[kq] = *(const LAS bf16x8*)(sl + GL_QB + cloc * 80 + kq * 32 + hi * 16);
#pragma unroll
        for (int kq = 0; kq < 2; ++kq) {
            P0 = __builtin_amdgcn_mfma_f32_32x32x16_bf16(*(const LAS bf16x8*)(sl + GL_KB + r32 * 80 + kq * 32 + hi * 16), qfr[kq], P0, 0, 0, 0);
            P1 = __builtin_amdgcn_mfma_f32_32x32x16_bf16(*(const LAS bf16x8*)(sl + GL_KB + (32 + r32) * 80 + kq * 32 + hi * 16), qfr[kq], P1, 0, 0, 0);
            O0 = __builtin_amdgcn_mfma_f32_32x32x16_bf16(*(const LAS bf16x8*)(sl + GL_ST + r32 * 80 + kq * 32 + hi * 16), qfr[kq], O0, 0, 0, 0);
            O1 = __builtin_amdgcn_mfma_f32_32x32x16_bf16(*(const LAS bf16x8*)(sl + GL_ST + (32 + r32) * 80 + kq * 32 + hi * 16), qfr[kq], O1, 0, 0, 0);
        }
#pragma unroll
        for (int r = 0; r < 16; ++r) { const int s0 = crow(r, hi); if (s0 > cloc) P0[r] = 0.f; if (s0 + 32 > cloc) P1[r] = 0.f; }
    }
    __syncthreads();
    {
        unsigned wq[8], wk[8], wsx[8];
#pragma unroll
        for (int i = 0; i < 8; ++i) { const float e0 = __expf(bb[2 * i]), e1 = __expf(bb[2 * i + 1]), i0 = __expf(-bb[2 * i]), i1 = __expf(-bb[2 * i + 1]);
            wq[i] = cvtpk(qq[2 * i] * e0, qq[2 * i + 1] * e1); wk[i] = cvtpk(kk[2 * i] * i0, kk[2 * i + 1] * i1); wsx[i] = cvtpk(sbv[2 * i], sbv[2 * i + 1]); }
        LAS u32x4* dq = (LAS u32x4*)(sl + GL_QB + lane * 80 + 32 * m); dq[0] = (u32x4){wq[0], wq[1], wq[2], wq[3]}; dq[1] = (u32x4){wq[4], wq[5], wq[6], wq[7]};
        LAS u32x4* dk = (LAS u32x4*)(sl + GL_KB + lane * 80 + 32 * m); dk[0] = (u32x4){wk[0], wk[1], wk[2], wk[3]}; dk[1] = (u32x4){wk[4], wk[5], wk[6], wk[7]};
        LAS u32x4* dsx = (LAS u32x4*)(sl + GL_ST + lane * 80 + 32 * m); dsx[0] = (u32x4){wsx[0], wsx[1], wsx[2], wsx[3]}; dsx[1] = (u32x4){wsx[4], wsx[5], wsx[6], wsx[7]};
    }
    __syncthreads();
    {
        f32x16 B0, B1;
#pragma unroll
        for (int r = 0; r < 16; ++r) { B0[r] = 0.f; B1[r] = 0.f; }
        bf16x8 qfr[2];
#pragma unroll
        for (int kq = 0; kq < 2; ++kq) qfr[kq] = *(const LAS bf16x8*)(sl + GL_QB + cloc * 80 + kq * 32 + hi * 16);
#pragma unroll
        for (int kq = 0; kq < 2; ++kq) {
            B0 = __builtin_amdgcn_mfma_f32_32x32x16_bf16(*(const LAS bf16x8*)(sl + GL_KB + r32 * 80 + kq * 32 + hi * 16), qfr[kq], B0, 0, 0, 0);
            B1 = __builtin_amdgcn_mfma_f32_32x32x16_bf16(*(const LAS bf16x8*)(sl + GL_KB + (32 + r32) * 80 + kq * 32 + hi * 16), qfr[kq], B1, 0, 0, 0);
            O0 = __builtin_amdgcn_mfma_f32_32x32x16_bf16(*(const LAS bf16x8*)(sl + GL_ST + r32 * 80 + kq * 32 + hi * 16), qfr[kq], O0, 0, 0, 0);
            O1 = __builtin_amdgcn_mfma_f32_32x32x16_bf16(*(const LAS bf16x8*)(sl + GL_ST + (32 + r32) * 80 + kq * 32 + hi * 16), qfr[kq], O1, 0, 0, 0);
        }
#pragma unroll
        for (int r = 0; r < 16; ++r) { const int s0 = crow(r, hi); if (s0 >= cloc) P0[r] += B0[r]; if (s0 + 32 >= cloc) P1[r] += B1[r]; }
    }
    {
        u32x4 pw[4];
        pw[0] = (u32x4){cvtpk(P0[0], P0[1]), cvtpk(P0[2], P0[3]), cvtpk(P0[4], P0[5]), cvtpk(P0[6], P0[7])};
        pw[1] = (u32x4){cvtpk(P0[8], P0[9]), cvtpk(P0[10], P0[11]), cvtpk(P0[12], P0[13]), cvtpk(P0[14], P0[15])};
        pw[2] = (u32x4){cvtpk(P1[0], P1[1]), cvtpk(P1[2], P1[3]), cvtpk(P1[4], P1[5]), cvtpk(P1[6], P1[7])};
        pw[3] = (u32x4){cvtpk(P1[8], P1[9]), cvtpk(P1[10], P1[11]), cvtpk(P1[12], P1[13]), cvtpk(P1[14], P1[15])};
#pragma unroll
        for (int ks = 0; ks < 4; ++ks) {
            const bf16x8 pa = __builtin_bit_cast(bf16x8, pw[ks]);
            const LAS unsigned char* vp = sl + GL_VT + r32 * 136 + (16 * ks + 4 * hi) * 2;
            const s16x4 a0 = *(const LAS s16x4*)vp, a1 = *(const LAS s16x4*)(vp + 16), c0 = *(const LAS s16x4*)(vp + 32 * 136), c1 = *(const LAS s16x4*)(vp + 32 * 136 + 16);
            O0 = __builtin_amdgcn_mfma_f32_32x32x16_bf16((bf16x8){a0[0], a0[1], a0[2], a0[3], a1[0], a1[1], a1[2], a1[3]}, pa, O0, 0, 0, 0);
            O1 = __builtin_amdgcn_mfma_f32_32x32x16_bf16((bf16x8){c0[0], c0[1], c0[2], c0[3], c1[0], c1[1], c1[2], c1[3]}, pa, O1, 0, 0, 0);
        }
    }
    {
        float ss = 0.f;
#pragma unroll
        for (int r = 0; r < 16; ++r) ss += O0[r] * O0[r] + O1[r] * O1[r];
        ss += __shfl_xor(ss, 32);
        const float rstd = rsqrtf(ss * (1.0f / 64.0f) + EPS);
        const size_t rowc = (size_t)(R0 + cloc);
        const bf16_t* rp = PROJ + rowc * NPROJ + C_AR + 64 * h; bf16_t* op = MIX + rowc * DM + 64 * h;
#pragma unroll
        for (int g = 0; g < 4; ++g) {
            const int v0 = 8 * g + 4 * hi;
            const s16x4 ra = rga[g], rb = rgb[g];
            const f32x4 ga = *(const f32x4*)(gain + v0), gbn = *(const f32x4*)(gain + 32 + v0);
            float ya[4], yb[4];
#pragma unroll
            for (int j = 0; j < 4; ++j) { ya[j] = O0[4 * g + j] * rstd * ga[j] * silu_f(bf2f((unsigned short)ra[j])); yb[j] = O1[4 * g + j] * rstd * gbn[j] * silu_f(bf2f((unsigned short)rb[j])); }
            *(u32x2*)(op + v0) = (u32x2){cvtpk(ya[0], ya[1]), cvtpk(ya[2], ya[3])};
            *(u32x2*)(op + 32 + v0) = (u32x2){cvtpk(yb[0], yb[1]), cvtpk(yb[2], yb[3])};
        }
    }
    __syncthreads();
}


struct Attn2Desc { const bf16_t* Q; bf16_t* O; const bf16_t* Klat; const bf16_t* Kctx; const bf16_t* Vt; int nctx, nloc0, nloc, win, qpos0, has_sink, rot; float sinkA, sinkB; };
__device__ __forceinline__ void attn2_tile(const Attn2Desc& u, const LAS unsigned char* Kl, int T, int qlo, int qpos, int r32, int hi,
                                           const bf16x8 (&qA)[4], const bf16x8 (&qB)[4], f32x16& oA0, f32x16& oA1, f32x16& oB0, f32x16& oB1, float& lA, float& lB) {
        const bool masked = u.win && T < 128;
        const bool active = !masked || (64 * T <= qlo + 31 + 128 && 64 * T + 63 >= qlo - 128);
        if (active) {
            const LAS unsigned char* Vl = Kl + 64 * KSTR;
            f32x16 pA0, pA1, pB0, pB1;
#pragma unroll
            for (int r = 0; r < 16; ++r) { pA0[r] = 0.f; pA1[r] = 0.f; pB0[r] = 0.f; pB1[r] = 0.f; }
#pragma unroll
            for (int d0 = 0; d0 < 4; ++d0) {
                const bf16x8 k0 = *(const LAS bf16x8*)(Kl + r32 * KSTR + d0 * 32 + hi * 16), k1 = *(const LAS bf16x8*)(Kl + (r32 + 32) * KSTR + d0 * 32 + hi * 16);
                pA0 = __builtin_amdgcn_mfma_f32_32x32x16_bf16(k0, qA[d0], pA0, 0, 0, 0); pA1 = __builtin_amdgcn_mfma_f32_32x32x16_bf16(k1, qA[d0], pA1, 0, 0, 0);
                pB0 = __builtin_amdgcn_mfma_f32_32x32x16_bf16(k0, qB[d0], pB0, 0, 0, 0); pB1 = __builtin_amdgcn_mfma_f32_32x32x16_bf16(k1, qB[d0], pB1, 0, 0, 0);
            }
            if (masked) {
                asm volatile("" ::: "memory");
                const int kb = 64 * T - qpos;
#pragma unroll
                for (int r = 0; r < 16; ++r) { const int rel = kb + crow(r, hi);
                    if (rel < -128 || rel > 128) { pA0[r] = -INFINITY; pB0[r] = -INFINITY; }
                    if (rel + 32 < -128 || rel + 32 > 128) { pA1[r] = -INFINITY; pB1[r] = -INFINITY; } }
            }
            bf16x8 vf0[4], vf1[4];
#pragma unroll
            for (int ks = 0; ks < 4; ++ks) {
                const LAS unsigned char* vp = Vl + r32 * VSTR + (16 * ks + 4 * hi) * 2;
                const s16x4 a0 = *(const LAS s16x4*)vp, a1 = *(const LAS s16x4*)(vp + 16);
                const s16x4 c0 = *(const LAS s16x4*)(vp + 32 * VSTR), c1 = *(const LAS s16x4*)(vp + 32 * VSTR + 16);
                vf0[ks] = (bf16x8){a0[0], a0[1], a0[2], a0[3], a1[0], a1[1], a1[2], a1[3]}; vf1[ks] = (bf16x8){c0[0], c0[1], c0[2], c0[3], c1[0], c1[1], c1[2], c1[3]};
            }
            u32x4 pwA[4], pwB[4];
            {
                float ps = 0.f;
#pragma unroll
                for (int r = 0; r < 16; ++r) { pA0[r] = __builtin_amdgcn_exp2f(pA0[r]); pA1[r] = __builtin_amdgcn_exp2f(pA1[r]); ps += pA0[r]; asm("" : "+v"(ps)); lA += pA1[r]; asm("" : "+v"(lA)); }
                lA += ps;
                pwA[0] = (u32x4){cvtpk(pA0[0], pA0[1]), cvtpk(pA0[2], pA0[3]), cvtpk(pA0[4], pA0[5]), cvtpk(pA0[6], pA0[7])};
                pwA[1] = (u32x4){cvtpk(pA0[8], pA0[9]), cvtpk(pA0[10], pA0[11]), cvtpk(pA0[12], pA0[13]), cvtpk(pA0[14], pA0[15])};
                pwA[2] = (u32x4){cvtpk(pA1[0], pA1[1]), cvtpk(pA1[2], pA1[3]), cvtpk(pA1[4], pA1[5]), cvtpk(pA1[6], pA1[7])};
                pwA[3] = (u32x4){cvtpk(pA1[8], pA1[9]), cvtpk(pA1[10], pA1[11]), cvtpk(pA1[12], pA1[13]), cvtpk(pA1[14], pA1[15])};
            }
            {
                float ps = 0.f;
#pragma unroll
                for (int r = 0; r < 16; ++r) { pB0[r] = __builtin_amdgcn_exp2f(pB0[r]); pB1[r] = __builtin_amdgcn_exp2f(pB1[r]); ps += pB0[r]; asm("" : "+v"(ps)); lB += pB1[r]; asm("" : "+v"(lB)); }
                lB += ps;
                pwB[0] = (u32x4){cvtpk(pB0[0], pB0[1]), cvtpk(pB0[2], pB0[3]), cvtpk(pB0[4], pB0[5]), cvtpk(pB0[6], pB0[7])};
                pwB[1] = (u32x4){cvtpk(pB0[8], pB0[9]), cvtpk(pB0[10], pB0[11]), cvtpk(pB0[12], pB0[13]), cvtpk(pB0[14], pB0[15])};
                pwB[2] = (u32x4){cvtpk(pB1[0], pB1[1]), cvtpk(pB1[2], pB1[3]), cvtpk(pB1[4], pB1[5]), cvtpk(pB1[6], pB1[7])};
                pwB[3] = (u32x4){cvtpk(pB1[8], pB1[9]), cvtpk(pB1[10], pB1[11]), cvtpk(pB1[12], pB1[13]), cvtpk(pB1[14], pB1[15])};
            }
#pragma unroll
            for (int ks = 0; ks < 4; ++ks) {
                const bf16x8 paA = __builtin_bit_cast(bf16x8, pwA[ks]), paB = __builtin_bit_cast(bf16x8, pwB[ks]);
                oA0 = __builtin_amdgcn_mfma_f32_32x32x16_bf16(vf0[ks], paA, oA0, 0, 0, 0); oA1 = __builtin_amdgcn_mfma_f32_32x32x16_bf16(vf1[ks], paA, oA1, 0, 0, 0);
                oB0 = __builtin_amdgcn_mfma_f32_32x32x16_bf16(vf0[ks], paB, oB0, 0, 0, 0); oB1 = __builtin_amdgcn_mfma_f32_32x32x16_bf16(vf1[ks], paB, oB1, 0, 0, 0);
            }
        }
}
__device__ __forceinline__ void attn2_unit(const Attn2Desc& u, LAS unsigned char* lds) {
    const int tid = opaque_tid(), lane = tid & 63, r32 = lane & 31, hi = lane >> 5, wid = tid >> 6;
    const bf16_t* Qw = u.Q + (size_t)(wid * 32 + r32) * NPROJ;
    bf16x8 qA[4], qB[4];
#pragma unroll
    for (int d0 = 0; d0 < 4; ++d0) { qA[d0] = *(const bf16x8*)(Qw + d0 * 16 + hi * 8); qB[d0] = *(const bf16x8*)(Qw + 64 + d0 * 16 + hi * 8); }
#pragma unroll
    for (int d0 = 0; d0 < 4; ++d0) asm volatile("" : "+v"(qA[d0]), "+v"(qB[d0]));
    f32x16 oA0, oA1, oB0, oB1;
#pragma unroll
    for (int r = 0; r < 16; ++r) { oA0[r] = 0.f; oA1[r] = 0.f; oB0[r] = 0.f; oB1[r] = 0.f; }
    float lA = 0.f, lB = 0.f;
    const int ntile = u.nctx + u.nloc;
    const int srow = tid >> 3, sch = tid & 7;
    const int qlo = u.qpos0 + wid * 32, qpos = qlo + r32;
    u32x4 kra, vra, krb, vrb;
#define ATT_TID(i, T_) const int j_##T_ = (i); const int T_ = j_##T_ < u.nctx ? 128 + j_##T_ : u.nloc0 + (j_##T_ - u.nctx)
#define ATT_LOAD(i, KR, VR) do { ATT_TID(i, Tl); KR = *(const u32x4*)(u.Klat + (size_t)Tl * 4096 + srow * 64 + sch * 8); VR = *(const u32x4*)(u.Vt + (size_t)Tl * 4096 + srow * 64 + sch * 8); } while (0)
#define ATT_STORE(buf, KR, VR) do { LAS unsigned char* kb_ = lds + (buf) * ABUF; *(LAS u32x4*)(kb_ + srow * KSTR + sch * 16) = KR; \
        LAS u32x2* vd_ = (LAS u32x2*)(kb_ + 64 * KSTR + srow * VSTR + sch * 16); vd_[0] = (u32x2){VR.x, VR.y}; vd_[1] = (u32x2){VR.z, VR.w}; } while (0)
    ATT_LOAD(0, kra, vra); ATT_STORE(0, kra, vra);
    ATT_LOAD(1, kra, vra);
    __syncthreads();
    for (int i = 0; i < ntile; i += 2) {
        if (i + 2 < ntile) ATT_LOAD(i + 2, krb, vrb);
        { ATT_TID(i, T0); attn2_tile(u, lds, T0, qlo, qpos, r32, hi, qA, qB, oA0, oA1, oB0, oB1, lA, lB); }
        ATT_STORE(1, kra, vra);
        __syncthreads();
        if (i + 3 < ntile) ATT_LOAD(i + 3, kra, vra);
        { ATT_TID(i + 1, T1); attn2_tile(u, lds + ABUF, T1, qlo, qpos, r32, hi, qA, qB, oA0, oA1, oB0, oB1, lA, lB); }
        if (i + 2 < ntile) ATT_STORE(0, krb, vrb);
        __syncthreads();
    }
#undef ATT_LOAD
#undef ATT_STORE
#undef ATT_TID
    float ltA = lA + __shfl_xor(lA, 32), ltB = lB + __shfl_xor(lB, 32);
    if (u.has_sink) { ltA += __builtin_amdgcn_exp2f(u.sinkA); ltB += __builtin_amdgcn_exp2f(u.sinkB); }
    const float invA = 1.0f / ltA, invB = 1.0f / ltB;
    bf16_t* Ow = u.O + (size_t)(wid * 32 + r32) * DM;
#pragma unroll
    for (int g = 0; g < 4; ++g) {
        u32x2 w0, w1, w2, w3;
        w0.x = cvtpk(oA0[4 * g] * invA, oA0[4 * g + 1] * invA); w0.y = cvtpk(oA0[4 * g + 2] * invA, oA0[4 * g + 3] * invA);
        w1.x = cvtpk(oA1[4 * g] * invA, oA1[4 * g + 1] * invA); w1.y = cvtpk(oA1[4 * g + 2] * invA, oA1[4 * g + 3] * invA);
        w2.x = cvtpk(oB0[4 * g] * invB, oB0[4 * g + 1] * invB); w2.y = cvtpk(oB0[4 * g + 2] * invB, oB0[4 * g + 3] * invB);
        w3.x = cvtpk(oB1[4 * g] * invB, oB1[4 * g + 1] * invB); w3.y = cvtpk(oB1[4 * g + 2] * invB, oB1[4 * g + 3] * invB);
        *(u32x2*)(Ow + 8 * g + 4 * hi) = w0; *(u32x2*)(Ow + 32 + 8 * g + 4 * hi) = w1;
        *(u32x2*)(Ow + 64 + 8 * g + 4 * hi) = w2; *(u32x2*)(Ow + 96 + 8 * g + 4 * hi) = w3;
    }
}

__device__ __forceinline__ void attn2_phase(bf16_t* PROJ, bf16_t* VT, bf16_t* KT, bf16_t* MIX, const float* sink, bool need_ctx, LAS unsigned char* lds) {
    const int G = gridDim.x; const int bx = opaque_bid(); const int vcu = (G % 8 == 0) ? (bx % 8) * (G / 8) + bx / 8 : bx;
    const int NG = 1024, NW = 512, NCG = need_ctx ? 32 : 0, NCW = need_ctx ? 16 : 0, total = NG + NW + NCG + NCW;
    for (int it = vcu; it < total; it += G) {
        Attn2Desc u; int e = it; u.rot = 0;
        if (e < NG) { const int qt = e & 31, hp = (e >> 5) & 3, b = e >> 7, kvh = hp >> 1, h = 2 * hp; const size_t qrow = (size_t)b * SEQL + 256 * qt;
            u.Q = PROJ + qrow * NPROJ + C_GQ + 64 * h; u.O = MIX + qrow * DM + 256 + 64 * h;
            u.Klat = KT + (size_t)((b * 2 + 0) * 2 + kvh) * 132 * 4096; u.Kctx = u.Klat;
            u.Vt = VT + (size_t)((b * 2 + 0) * 2 + kvh) * 132 * 4096; u.nctx = 4; u.nloc0 = 0; u.nloc = 128; u.win = 0; u.qpos0 = 0; u.has_sink = 0; u.sinkA = 0.f; u.sinkB = 0.f; u.rot = 0;
        } else if ((e -= NG) < NW) { const int qt = e & 31, kvh = (e >> 5) & 1, b = e >> 6, h = 2 * kvh; const size_t qrow = (size_t)b * SEQL + 256 * qt;
            u.Q = PROJ + qrow * NPROJ + C_WQ + 64 * h; u.O = MIX + qrow * DM + 768 + 64 * h;
            u.Klat = KT + (size_t)((b * 2 + 1) * 2 + kvh) * 132 * 4096; u.Kctx = u.Klat;
            u.Vt = VT + (size_t)((b * 2 + 1) * 2 + kvh) * 132 * 4096; u.nctx = 4; const int t0 = 4 * qt - 2 < 0 ? 0 : 4 * qt - 2, t1 = 4 * qt + 6 > 128 ? 128 : 4 * qt + 6;
            u.nloc0 = t0; u.nloc = t1 - t0; u.win = 1; u.qpos0 = 256 * qt; u.has_sink = 1; u.sinkA = sink[h] * LOG2E; u.sinkB = sink[h + 1] * LOG2E;
        } else if ((e -= NW) < NCG) { const int hp = e & 3, b = e >> 2, kvh = hp >> 1, h = 2 * hp; const size_t qrow = (size_t)NLAT + b * NCTX;
            u.Q = PROJ + qrow * NPROJ + C_GQ + 64 * h; u.O = MIX + qrow * DM + 256 + 64 * h;
            u.Klat = KT + (size_t)((b * 2 + 0) * 2 + kvh) * 132 * 4096; u.Kctx = u.Klat;
            u.Vt = VT + (size_t)((b * 2 + 0) * 2 + kvh) * 132 * 4096; u.nctx = 4; u.nloc0 = 0; u.nloc = 0; u.win = 0; u.qpos0 = 0; u.has_sink = 0; u.sinkA = 0.f; u.sinkB = 0.f;
        } else { e -= NCG; const int kvh = e & 1, b = e >> 1, h = 2 * kvh; const size_t qrow = (size_t)NLAT + b * NCTX;
            u.Q = PROJ + qrow * NPROJ + C_WQ + 64 * h; u.O = MIX + qrow * DM + 768 + 64 * h;
            u.Klat = KT + (size_t)((b * 2 + 1) * 2 + kvh) * 132 * 4096; u.Kctx = u.Klat;
            u.Vt = VT + (size_t)((b * 2 + 1) * 2 + kvh) * 132 * 4096; u.nctx = 4; u.nloc0 = 0; u.nloc = 0; u.win = 0; u.qpos0 = 0; u.has_sink = 1; u.sinkA = sink[h] * LOG2E; u.sinkB = sink[h + 1] * LOG2E;
        }
        attn2_unit(u, lds);
    }
}
__device__ __forceinline__ float attn_score_bound(const float* gqg, const float* gkg, const float* wqg, const float* wkg, const float* sink) {
    const int lane = opaque_tid() & 63;
    float a = fabsf(gqg[lane]), b = fabsf(gkg[lane]), c = fabsf(wqg[lane]), d = fabsf(wkg[lane]);
#pragma unroll
    for (int o = 1; o < 64; o <<= 1) { a = fmaxf(a, __shfl_xor(a, o)); b = fmaxf(b, __shfl_xor(b, o)); c = fmaxf(c, __shfl_xor(c, o)); d = fmaxf(d, __shfl_xor(d, o)); }
    float s = fmaxf(fmaxf(fabsf(sink[0]), fabsf(sink[1])), fmaxf(fabsf(sink[2]), fabsf(sink[3]))) * LOG2E;
    const float bd = fmaxf(fmaxf(a * b, c * d) * (64.0f * QSCALE), s);
    return (bd == bd) ? bd : 1e30f;
}

__device__ __forceinline__ void attn_phase(bf16_t* PROJ, bf16_t* VT, bf16_t* KT, bf16_t* MIX, const float* sink, bool need_ctx, LAS unsigned char* lds) {
    const int G = gridDim.x; const int bx = opaque_bid(); const int vcu = (G % 8 == 0) ? (bx % 8) * (G / 8) + bx / 8 : bx;
    const int NG = 2048, NW = 1024, NCG = need_ctx ? 64 : 0, NCW = need_ctx ? 32 : 0, total = NG + NW + NCG + NCW;
    for (int it = vcu; it < total; it += G) {
        AttnDesc u; int e = it;
        if (e < NG) { const int qt = e & 31, h = (e >> 5) & 7, b = e >> 8, kvh = h >> 2; const size_t qrow = (size_t)b * SEQL + 256 * qt;
            u.Q = PROJ + qrow * NPROJ + C_GQ + 64 * h; u.O = MIX + qrow * DM + 256 + 64 * h;
            u.Klat = KT + (size_t)((b * 2 + 0) * 2 + kvh) * 132 * 4096; u.Kctx = u.Klat;
            u.Vt = VT + (size_t)((b * 2 + 0) * 2 + kvh) * 132 * 4096; u.nctx = 4; u.nloc0 = 0; u.nloc = 128; u.win = 0; u.qpos0 = 0; u.has_sink = 0; u.sinkl2 = 0.f;
        } else if ((e -= NG) < NW) { const int qt = e & 31, h = (e >> 5) & 3, b = e >> 7, kvh = h >> 1; const size_t qrow = (size_t)b * SEQL + 256 * qt;
            u.Q = PROJ + qrow * NPROJ + C_WQ + 64 * h; u.O = MIX + qrow * DM + 768 + 64 * h;
            u.Klat = KT + (size_t)((b * 2 + 1) * 2 + kvh) * 132 * 4096; u.Kctx = u.Klat;
            u.Vt = VT + (size_t)((b * 2 + 1) * 2 + kvh) * 132 * 4096; u.nctx = 4; const int t0 = 4 * qt - 2 < 0 ? 0 : 4 * qt - 2, t1 = 4 * qt + 6 > 128 ? 128 : 4 * qt + 6;
            u.nloc0 = t0; u.nloc = t1 - t0; u.win = 1; u.qpos0 = 256 * qt; u.has_sink = 1; u.sinkl2 = sink[h] * LOG2E;
        } else if ((e -= NW) < NCG) { const int h = e & 7, b = e >> 3, kvh = h >> 2; const size_t qrow = (size_t)NLAT + b * NCTX;
            u.Q = PROJ + qrow * NPROJ + C_GQ + 64 * h; u.O = MIX + qrow * DM + 256 + 64 * h;
            u.Klat = KT + (size_t)((b * 2 + 0) * 2 + kvh) * 132 * 4096; u.Kctx = u.Klat;
            u.Vt = VT + (size_t)((b * 2 + 0) * 2 + kvh) * 132 * 4096; u.nctx = 4; u.nloc0 = 0; u.nloc = 0; u.win = 0; u.qpos0 = 0; u.has_sink = 0; u.sinkl2 = 0.f;
        } else { e -= NCG; const int h = e & 3, b = e >> 2, kvh = h >> 1; const size_t qrow = (size_t)NLAT + b * NCTX;
            u.Q = PROJ + qrow * NPROJ + C_WQ + 64 * h; u.O = MIX + qrow * DM + 768 + 64 * h;
            u.Klat = KT + (size_t)((b * 2 + 1) * 2 + kvh) * 132 * 4096; u.Kctx = u.Klat;
            u.Vt = VT + (size_t)((b * 2 + 1) * 2 + kvh) * 132 * 4096; u.nctx = 4; u.nloc0 = 0; u.nloc = 0; u.win = 0; u.qpos0 = 0; u.has_sink = 1; u.sinkl2 = sink[h] * LOG2E;
        }
        attn_unit(u, lds);
    }
}

#define XB_TMO      128
#define XB_XCNT(j)  (256  + 64 * (j))
#define XB_XSUB(j)  (1280 + 64 * (j))
#define XB_XGEN(j)  (2304 + 64 * (j))
#define XB_TOP      3328
#define XB_TOPGEN   3392
#define XCD_BAR_WORDS 3456
#define XB_SPIN_CAP (1u << 18)

__device__ __forceinline__ unsigned xb_ld(unsigned* p)              { return __hip_atomic_load(p, __ATOMIC_RELAXED, __HIP_MEMORY_SCOPE_AGENT); }
__device__ __forceinline__ unsigned xb_add(unsigned* p, unsigned v) { return __hip_atomic_fetch_add(p, v, __ATOMIC_RELAXED, __HIP_MEMORY_SCOPE_AGENT); }
__device__ __forceinline__ unsigned xb_xcc_id() { return (unsigned)__builtin_amdgcn_s_getreg((3 << 11) | 20) & 0xFu; }
#define XB_SPIN(cond, bar) do { unsigned _sp = 0; while (cond) { __builtin_amdgcn_s_sleep(1); \
    if ((++_sp & 255u) == 0u) { if (xb_ld(&(bar)[XB_TMO])) break; if (_sp > XB_SPIN_CAP) { atomicAdd(&(bar)[XB_TMO], 1u); break; } } } } while (0)

struct XcdBarrier {
    unsigned* bar; unsigned x;
    volatile LAS unsigned* st;
};

__device__ __forceinline__ XcdBarrier xcd_barrier_post(unsigned* bar, volatile LAS unsigned* st) {
    XcdBarrier b; b.bar = bar; b.x = xb_xcc_id(); b.st = st;
    if (threadIdx.x == 0) (void)xb_add(&bar[XB_XCNT(b.x)], 1u);
    return b;
}
__device__ __forceinline__ void xcd_barrier_complete(unsigned* bar, unsigned x, unsigned& nloc, unsigned& nx) {
    const unsigned G = gridDim.x * gridDim.y * gridDim.z;
    unsigned sum, cnt, mine, sp = 0u;
    for (;;) {
        sum = 0u; cnt = 0u; mine = 0u;
#pragma unroll
        for (unsigned j = 0; j < 16; ++j) { const unsigned c = xb_ld(&bar[XB_XCNT(j)]); sum += c; cnt += (c > 0u) ? 1u : 0u; mine = (j == x) ? c : mine; }
        if (sum == G) break;
        __builtin_amdgcn_s_sleep(1);
        if ((++sp & 255u) == 0u) { if (xb_ld(&bar[XB_TMO])) break; if (sp > XB_SPIN_CAP) { atomicAdd(&bar[XB_TMO], 1u); break; } }
    }
    nloc = mine > 0u ? mine : 1u; nx = cnt > 0u ? cnt : 1u;
}

__device__ __forceinline__ void xcd_barrier(const XcdBarrier& b) {
    asm volatile("s_waitcnt vmcnt(0)" ::: "memory");
    __syncthreads();
    if (threadIdx.x == 0) {
        unsigned* bar = b.bar;
        __builtin_amdgcn_s_waitcnt(0);
        unsigned nloc = b.st[0], nx = b.st[1];
        if (nloc == 0u) { xcd_barrier_complete(bar, b.x, nloc, nx); b.st[0] = nloc; b.st[1] = nx; }
        const unsigned old = xb_add(&bar[XB_XSUB(b.x)], 1u);
        const unsigned gen = old / nloc;
        if (old + 1u == (gen + 1u) * nloc) {
            __builtin_amdgcn_fence(__ATOMIC_RELEASE, "agent");
            asm volatile("s_waitcnt vmcnt(0)" ::: "memory");
            const unsigned og = xb_add(&bar[XB_TOP], 1u);
            const unsigned tg = og / nx;
            if (og + 1u == (tg + 1u) * nx) xb_add(&bar[XB_TOPGEN], 1u);
            else XB_SPIN(xb_ld(&bar[XB_TOPGEN]) == tg, bar);
            __builtin_amdgcn_fence(__ATOMIC_ACQUIRE, "agent");
            xb_add(&bar[XB_XGEN(b.x)], 1u);
            asm volatile("s_waitcnt vmcnt(0)" ::: "memory");
        } else {
            XB_SPIN(xb_ld(&bar[XB_XGEN(b.x)]) == gen, bar);
            __builtin_amdgcn_fence(__ATOMIC_ACQUIRE, "agent");
            asm volatile("s_waitcnt vmcnt(0)" ::: "memory");
        }
    }
    __syncthreads();
}

constexpr int LDS_BYTES = 147456;
constexpr int N_PHASES = 20;

__global__ void __launch_bounds__(512, 2) hymba_fwd(Args a) {
    extern __shared__ __attribute__((aligned(16))) unsigned char lds_raw[];
    LAS unsigned char* lds = (LAS unsigned char*)lds_raw;
    cg::grid_group grid = cg::this_grid();
    volatile LAS unsigned* MISC = (volatile LAS unsigned*)(lds + 131072 + 320);
    if (threadIdx.x < 32) MISC[threadIdx.x] = 0u;
    __syncthreads();
    XcdBarrier xbar = xcd_barrier_post((unsigned*)a.ws + 4096, MISC + 8);
    const int G = gridDim.x;
    for (int ph = a.ph_lo; ph < a.ph_hi; ++ph) {
    __attribute__((address_space(1))) unsigned char* wsg = (__attribute__((address_space(1))) unsigned char*)a.ws; asm volatile("" : "+s"(wsg));
    unsigned char* ws = (unsigned char*)wsg;
    const int bid = opaque_bid();
    float* MOD = (float*)(ws + WS_MOD); float* ROPE = (float*)(ws + WS_ROPE);
    bf16_t* XN = (bf16_t*)(ws + WS_XN); bf16_t* HID = (bf16_t*)(ws + WS_HID); bf16_t* PROJ = (bf16_t*)(ws + WS_HID);
    bf16_t* VT = (bf16_t*)(ws + WS_VT); float* Gg = (float*)(ws + WS_G); float* DS = (float*)(ws + WS_DS); float* DEC = (float*)(ws + WS_DEC); bf16_t* MIX = (bf16_t*)a.out; bf16_t* XB = (bf16_t*)(ws + WS_XB); bf16_t* KT = (bf16_t*)(ws + WS_KT);
    float* SSQ = (float*)(ws + WS_SSQ); const float* GM = (const float*)(ws + WS_GM); const float* BIAS = (const float*)(ws + WS_BIAS);
        if (ph == 0) { prologue_phase(a, lds); }
        else if (ph == 1) { bias_phase(a); norm_phase(a.in[0], a.in[2], XN, XB, a.in[6], MOD, SSQ, MT); }
        else {
            const int idx = ph - 2, l = idx / 9, j = idx % 9, s = j + 1 + (j >= 2 ? 1 : 0) + (j >= 7 ? 1 : 0); const bool last = (l == 1);
            const unsigned char* wl = ws + WS_W + (size_t)l * W_LAYER; const float* modl = MOD + (size_t)l * 9 * MODW;
            switch (s) {
            case 1: case 10: {
                const int M = (s == 10 && last) ? NLAT : MT; const int w = s == 1 ? 0 : 2;
                pg8::Gemm g{XN, (const bf16_t*)(wl + (s == 1 ? WO_F1I : WO_F2I)), M, 2 * FH, DM}; pg8::StaticOrder S; S.init(M, 2 * FH, G, bid);
                pg8::EpiSwiglu E{HID, SSQ + (size_t)(l * 3 + w) * MT, BIAS + (size_t)(l * 3 + w) * 9 * BIASN};
                pg8::gemm_phase<pg8::EpiSwiglu, pg8::StaticOrder, true, true>(lds, g, S, E);
            } break;
            case 2: case 11: {
                const int M = (s == 11 && last) ? NLAT : MT;
                const int ni = s == 2 ? l * 3 + 1 : 3;
                const bool has_next = !(s == 11 && last);
                pg8::Gemm g{HID, (const bf16_t*)(wl + (s == 2 ? WO_F1O : WO_F2O)), M, DM, FH}; pg8::StaticOrder S; S.init(M, DM, G, bid);
                pg8::EpiResid E{XB, a.out, modl + (s == 2 ? 2 : 8) * DM, XN, GM + (size_t)ni * 9 * DM, SSQ + (size_t)ni * MT, 0.5f, has_next ? 1 : 0, has_next ? 0 : 1};
                pg8::gemm_phase<pg8::EpiResid, pg8::StaticOrder, true, true>(lds, g, S, E);
            } break;
            case 4: {
                pg8::Gemm g{XN, (const bf16_t*)(wl + WO_MI), MT, NPROJ, DM}; pg8::StaticOrder S; S.init(MT, NPROJ, G, bid);
                pg8::EpiInproj E{PROJ, Gg, a.in[13] + l * 128, a.in[15] + l * 128, SSQ + (size_t)(l * 3 + 1) * MT, BIAS + (size_t)(l * 3 + 1) * 9 * BIASN};
                pg8::gemm_phase<pg8::EpiInproj, pg8::StaticOrder, true, true>(lds, g, S, E);
            } break;
            case 5: {
                for (int un = bid; un < MT / 64; un += G) prep_unit(un, PROJ, VT, KT, ROPE, a.in[17] + l * 64, a.in[18] + l * 64, a.in[19] + l * 64, a.in[20] + l * 64, lds);
                for (int gp = bid; gp < 32 * 33; gp += G) gla_g1_mfma(gp, PROJ, Gg, DS, DEC, lds);
            } break;
            case 6: {
                for (int ch = bid; ch < 256; ch += G) gla_scan_chain(ch, DS, DEC);
                __syncthreads();
                { const float bound = attn_score_bound(a.in[17] + l * 64, a.in[18] + l * 64, a.in[19] + l * 64, a.in[20] + l * 64, a.in[21] + l * 4);
                  if (__builtin_amdgcn_readfirstlane(bound <= 40.0f ? 1 : 0)) attn2_phase(PROJ, VT, KT, MIX, a.in[21] + l * 4, !last, lds);
                  else attn_phase(PROJ, VT, KT, MIX, a.in[21] + l * 4, !last, lds); }
            } break;
            case 7: {
                for (int gp = bid; gp < 32 * 33; gp += G) { if (last && (gp % 33) == 0) continue; gla_g3_mfma(gp, PROJ, Gg, DS, a.in[16] + l * 64, MIX, lds); }
            } break;
            case 8: {
                const int M = last ? NLAT : MT; const int ni = l * 3 + 2;
                pg8::Gemm g{MIX, (const bf16_t*)(wl + WO_MO), M, DM, DM}; pg8::StaticOrder S; S.init(M, DM, G, bid);
                pg8::EpiResid E{XB, a.out, modl + 5 * DM, XN, GM + (size_t)ni * 9 * DM, SSQ + (size_t)ni * MT, 1.0f, 1, 0};
                pg8::gemm_phase<pg8::EpiResid, pg8::StaticOrder, true, true>(lds, g, S, E);
            } break;
            default: break;
            }
        }
        if (ph + 1 < a.ph_hi) { if (a.ph_lo < 0) grid.sync(); else xcd_barrier(xbar); }
    }
}

#ifndef MK_PER_PHASE
#define MK_PER_PHASE 0
#endif
extern "C" void kernel_launch(void* const* d_in, const int* in_sizes, int n_in, void* d_out, int out_size, void* d_ws, size_t ws_size, hipStream_t stream) {
    static int grid = 0;
    if (grid == 0) {
        if (n_in != 25 || ws_size < WS_END) { fprintf(stderr, "kernel_launch: unexpected n_in %d / ws_size %zu (need %zu)\n", n_in, ws_size, (size_t)WS_END); grid = -1; return; }
        int dev = 0, cus = 0, per_cu = 0;
        hipGetDevice(&dev); hipDeviceGetAttribute(&cus, hipDeviceAttributeMultiprocessorCount, dev);
        if (hipFuncSetAttribute((const void*)hymba_fwd, hipFuncAttributeMaxDynamicSharedMemorySize, LDS_BYTES) != hipSuccess) { fprintf(stderr, "kernel_launch: hipFuncSetAttribute failed\n"); grid = -1; return; }
        if (hipOccupancyMaxActiveBlocksPerMultiprocessor(&per_cu, (const void*)hymba_fwd, 512, LDS_BYTES) != hipSuccess || per_cu < 1) { fprintf(stderr, "kernel_launch: occupancy query says %d\n", per_cu); per_cu = 1; }
        (void)hipGetLastError();
        grid = cus * 1;
    }
    if (grid < 0) return;
    if (hipMemsetAsync(d_ws, 0, WS_CTLB + (size_t)6 * MT * 4, stream) != hipSuccess) { fprintf(stderr, "kernel_launch: memset failed\n"); return; }
    Args a{};
    for (int i = 0; i < 25; ++i) a.in[i] = (const float*)d_in[i];
    a.out = (float*)d_out; a.ws = (unsigned char*)d_ws;
#if MK_PER_PHASE
    for (int ph = 0; ph < N_PHASES; ++ph) { a.ph_lo = ph; a.ph_hi = ph + 1; hipLaunchKernelGGL(hymba_fwd, dim3(grid), dim3(512), LDS_BYTES, stream, a); }
#else
    a.ph_lo = 0; a.ph_hi = N_PHASES;
    void* args[] = {&a};
    hipError_t e = hipLaunchCooperativeKernel((const void*)hymba_fwd, dim3(grid), dim3(512), args, LDS_BYTES, stream);
    if (e != hipSuccess) fprintf(stderr, "kernel_launch: cooperative launch failed: %s (grid %d)\n", hipGetErrorString(e), grid);
#endif
}
```
